# Optimizing an MI355X kernel written in HIP

```python
import jax, jax.numpy as jnp
from jax import lax
import numpy as np

D_MODEL = 1024
BATCH = 8
SEQ = 2048
DEPTH = 1

CHUNK = 64
N_MEM = 256
EPS = 1e-6
GDN_HEADS = 4
GDN_DK = 128
GDN_DV = 128
CONV_K = 4
DSA_HEADS = 8
DSA_HD = 64
IDX_HEADS = 16
IDX_HD = 64
TOPK_MAX = 256
XA_HEADS = 4
XA_HD = 128
D_FF = ((8 * D_MODEL + 3 * 256 - 1) // (3 * 256)) * 256

GDN_KEY_DIM = GDN_HEADS * GDN_DK
GDN_VAL_DIM = GDN_HEADS * GDN_DV
GDN_CONV_CH = 2 * GDN_KEY_DIM + GDN_VAL_DIM
DSA_DIM = DSA_HEADS * DSA_HD
IDX_Q_DIM = IDX_HEADS * IDX_HD
IN_SPLITS = (GDN_CONV_CH, GDN_VAL_DIM, GDN_HEADS, GDN_HEADS,
             DSA_DIM, DSA_DIM, DSA_DIM, IDX_Q_DIM, IDX_HD, IDX_HEADS)
D_IN = GDN_CONV_CH + GDN_VAL_DIM + 2 * GDN_HEADS + 3 * DSA_DIM + IDX_Q_DIM + IDX_HD + IDX_HEADS
D_MIX = GDN_VAL_DIM + DSA_DIM
XA_DIM = XA_HEADS * XA_HD

kernel_name = "hybrid_gdn_dsa_memxattn_block"


def rms_norm(x, g):
    xf = x.astype(jnp.float32)
    y = xf * lax.rsqrt(jnp.mean(xf * xf, axis=-1, keepdims=True) + EPS)
    return (y * g.astype(jnp.float32)).astype(x.dtype)


def l2norm(x):
    xf = x.astype(jnp.float32)
    return xf * lax.rsqrt(jnp.sum(xf * xf, axis=-1, keepdims=True) + EPS)


def split_cols(a, sizes):
    idx, s = [], 0
    for n in sizes[:-1]:
        s += n
        idx.append(s)
    return jnp.split(a, idx, axis=-1)


def alibi_slopes(n):
    return jnp.exp2(-8.0 * jnp.arange(1, n + 1, dtype=jnp.float32) / n)


def causal_conv(u, w):
    K, C = w.shape
    return lax.conv_general_dilated(u, w[:, None, :].astype(u.dtype), window_strides=(1,),
                                    padding=[(K - 1, 0)], dimension_numbers=('NWC', 'WIO', 'NWC'),
                                    feature_group_count=C)


def gated_delta_rule(q, k, v, g, beta):
    B, T, H, dk = q.shape
    dv = v.shape[-1]
    n = T // CHUNK

    def to_chunks(a):
        return jnp.moveaxis(a.reshape(B, n, CHUNK, *a.shape[2:]), 2, 3)

    qc, kc, vc = to_chunks(q), to_chunks(k), to_chunks(v)
    gc, bc = to_chunks(g), to_chunks(beta)
    decay = jnp.cumsum(gc, axis=-1)
    pos = jnp.arange(CHUNK)
    incl = pos[:, None] >= pos[None, :]
    strict = pos[:, None] > pos[None, :]
    diff = decay[..., :, None] - decay[..., None, :]
    gamma = jnp.exp(jnp.where(incl, diff, -jnp.inf))
    kb = kc * bc[..., None]
    vb = vc * bc[..., None]
    a_mat = jnp.where(strict, jnp.einsum('bnhid,bnhjd->bnhij', kb, kc) * gamma, 0.0)
    eye = jnp.eye(CHUNK, dtype=jnp.float32)
    t_mat = jax.lax.linalg.triangular_solve(eye + a_mat, jnp.broadcast_to(eye, a_mat.shape),
                                            left_side=True, lower=True)
    u = jnp.einsum('bnhij,bnhjd->bnhid', t_mat, vb)
    w = jnp.einsum('bnhij,bnhjd->bnhid', t_mat, kb * jnp.exp(decay)[..., None])
    qk = jnp.einsum('bnhid,bnhjd->bnhij', qc, kc) * gamma
    q_dec = qc * jnp.exp(decay)[..., None]
    k_dec = kc * jnp.exp(decay[..., -1:] - decay)[..., None]
    last = jnp.exp(decay[..., -1])

    def step(S, inp):
        qd, kd, u_, w_, qk_, l_ = inp
        v_new = u_ - jnp.einsum('bhcd,bhde->bhce', w_, S)
        o = jnp.einsum('bhcd,bhde->bhce', qd, S) + jnp.einsum('bhij,bhje->bhie', qk_, v_new)
        S = S * l_[..., None, None] + jnp.einsum('bhcd,bhce->bhde', kd, v_new)
        return S, o

    xs = tuple(jnp.moveaxis(a, 1, 0) for a in (q_dec, k_dec, u, w, qk, last))
    S0 = jnp.zeros((B, H, dk, dv), jnp.float32)
    _, o = lax.scan(step, S0, xs)
    o = jnp.moveaxis(jnp.moveaxis(o, 0, 1), 2, 3)
    return o.reshape(B, T, H, dv)


def gated_deltanet(qkv, z, b_logit, a_logit, conv_w, a_log, dt_bias, g_out):
    B, T, _ = qkv.shape
    qkv = jax.nn.silu(causal_conv(qkv, conv_w))
    q = l2norm(qkv[..., :GDN_KEY_DIM].reshape(B, T, GDN_HEADS, GDN_DK)) * (GDN_DK ** -0.5)
    k = l2norm(qkv[..., GDN_KEY_DIM:2 * GDN_KEY_DIM].reshape(B, T, GDN_HEADS, GDN_DK))
    v = qkv[..., 2 * GDN_KEY_DIM:].reshape(B, T, GDN_HEADS, GDN_DV).astype(jnp.float32)
    beta = jax.nn.sigmoid(b_logit.astype(jnp.float32))
    g = -jnp.exp(a_log.astype(jnp.float32)) * jax.nn.softplus(a_logit.astype(jnp.float32) + dt_bias.astype(jnp.float32))
    o = gated_delta_rule(q, k, v, g, beta)
    o = rms_norm(o, g_out) * jax.nn.silu(z.astype(jnp.float32).reshape(B, T, GDN_HEADS, GDN_DV))
    return o.reshape(B, T, GDN_VAL_DIM).astype(qkv.dtype)


def indexed_sparse_attention(q, k, v, q_idx, k_idx, w_idx, g_q, g_k):
    B, T, _ = q.shape
    topk = min(TOPK_MAX, T // 4)
    q = rms_norm(q.reshape(B, T, DSA_HEADS, DSA_HD), g_q)
    k = rms_norm(k.reshape(B, T, DSA_HEADS, DSA_HD), g_k).reshape(B, T, DSA_DIM)
    qi = q_idx.astype(jnp.float32).reshape(B, T, IDX_HEADS, IDX_HD)
    ki = k_idx.astype(jnp.float32)
    wi = w_idx.astype(jnp.float32) * (IDX_HEADS ** -0.5)
    slopes = alibi_slopes(DSA_HEADS)
    key_chunk = jnp.arange(T) // CHUNK

    def block(c):
        start = c * CHUNK
        qb = lax.dynamic_slice_in_dim(q, start, CHUNK, axis=1)
        qib = lax.dynamic_slice_in_dim(qi, start, CHUNK, axis=1)
        wib = lax.dynamic_slice_in_dim(wi, start, CHUNK, axis=1)
        dots = jnp.einsum('bqhd,bsd->bqhs', qib, ki) * (IDX_HD ** -0.5)
        score = jnp.einsum('bqh,bqhs->bqs', wib, jax.nn.relu(dots))
        admissible = key_chunk <= c
        score = jnp.where(admissible[None, None, :], score, -jnp.inf)
        _, sel = lax.top_k(score, topk)
        valid = admissible[sel]
        kg = jax.vmap(lambda kb, ib: kb[ib])(k, sel).reshape(B, CHUNK, topk, DSA_HEADS, DSA_HD)
        vg = jax.vmap(lambda vb, ib: vb[ib])(v, sel).reshape(B, CHUNK, topk, DSA_HEADS, DSA_HD)
        logits = jnp.einsum('bqhd,bqkhd->bhqk', qb, kg).astype(jnp.float32) * (DSA_HD ** -0.5)
        qpos = start + jnp.arange(CHUNK)
        dist = jnp.abs(qpos[None, :, None] - sel).astype(jnp.float32)
        logits = logits - slopes[None, :, None, None] * dist[:, None]
        logits = jnp.where(valid[:, None], logits, -jnp.inf)
        p = jax.nn.softmax(logits, axis=-1)
        out = jnp.einsum('bhqk,bqkhd->bqhd', p.astype(vg.dtype), vg)
        return out.reshape(B, CHUNK, DSA_DIM)

    outs = lax.map(block, jnp.arange(T // CHUNK))
    return jnp.moveaxis(outs, 0, 1).reshape(B, T, DSA_DIM)


def memory_cross_attention(h, m, w_q, w_kv, w_o, g_q, g_k):
    B, T, _ = h.shape
    M = m.shape[1]
    q = rms_norm((h @ w_q).reshape(B, T, XA_HEADS, XA_HD), g_q)
    k, v = jnp.split(m @ w_kv, 2, axis=-1)
    k = rms_norm(k.reshape(B, M, XA_HEADS, XA_HD), g_k)
    v = v.reshape(B, M, XA_HEADS, XA_HD)
    logits = jnp.einsum('bthd,bmhd->bhtm', q, k).astype(jnp.float32) * (XA_HD ** -0.5)
    p = jax.nn.softmax(logits, axis=-1)
    o = jnp.einsum('bhtm,bmhd->bthd', p.astype(v.dtype), v).reshape(B, T, XA_DIM)
    return o @ w_o


def setup_inputs(seed: int = 0) -> dict:
    key = jax.random.key(seed)
    ks = jax.random.split(key, 24)
    f32 = jnp.float32

    def dense(k, fan_in, fan_out):
        return jax.random.normal(k, (DEPTH, fan_in, fan_out), f32) * fan_in ** -0.5

    def gain(k, n):
        return 1.0 + 0.02 * jax.random.normal(k, (DEPTH, n), f32)

    x = jax.random.normal(ks[0], (BATCH, SEQ, D_MODEL), f32)
    mem = jax.random.normal(ks[1], (BATCH, N_MEM, D_MODEL), f32)
    dt = jnp.exp(jax.random.uniform(ks[6], (DEPTH, GDN_HEADS), f32, np.log(1e-3), np.log(1e-1)))
    return {
        "x": x,
        "mem": mem,
        "g_mix": gain(ks[2], D_MODEL),
        "w_in": dense(ks[3], D_MODEL, D_IN),
        "conv_w": jax.random.normal(ks[4], (DEPTH, CONV_K, GDN_CONV_CH), f32) * CONV_K ** -0.5,
        "a_log": jnp.log(jax.random.uniform(ks[5], (DEPTH, GDN_HEADS), f32, 1.0, 16.0)),
        "dt_bias": dt + jnp.log(-jnp.expm1(-dt)),
        "g_gdn_out": gain(ks[7], GDN_DV),
        "g_q_dsa": gain(ks[8], DSA_HD),
        "g_k_dsa": gain(ks[9], DSA_HD),
        "w_out": dense(ks[10], D_MIX, D_MODEL),
        "g_xattn": gain(ks[11], D_MODEL),
        "g_mem": gain(ks[12], D_MODEL),
        "w_xq": dense(ks[13], D_MODEL, XA_DIM),
        "w_xkv": dense(ks[14], D_MODEL, 2 * XA_DIM),
        "g_xq": gain(ks[15], XA_HD),
        "g_xk": gain(ks[16], XA_HD),
        "w_xo": dense(ks[17], XA_DIM, D_MODEL),
        "g_ffn": gain(ks[18], D_MODEL),
        "w_gu": dense(ks[19], D_MODEL, 2 * D_FF),
        "w_down": dense(ks[20], D_FF, D_MODEL),
    }


def reference(x, mem, g_mix, w_in, conv_w, a_log, dt_bias, g_gdn_out, g_q_dsa, g_k_dsa, w_out,
              g_xattn, g_mem, w_xq, w_xkv, g_xq, g_xk, w_xo, g_ffn, w_gu, w_down):
    for l in range(DEPTH):
        h = rms_norm(x, g_mix[l])
        proj = h @ w_in[l]
        (gdn_qkv, gdn_z, gdn_b, gdn_a, dsa_q, dsa_k, dsa_v,
         idx_q, idx_k, idx_w) = split_cols(proj, IN_SPLITS)
        y_a = gated_deltanet(gdn_qkv, gdn_z, gdn_b, gdn_a, conv_w[l], a_log[l], dt_bias[l], g_gdn_out[l])
        y_b = indexed_sparse_attention(dsa_q, dsa_k, dsa_v, idx_q, idx_k, idx_w, g_q_dsa[l], g_k_dsa[l])
        x = x + jnp.concatenate([y_a, y_b], axis=-1) @ w_out[l]
        h = rms_norm(x, g_xattn[l])
        m = rms_norm(mem, g_mem[l])
        x = x + memory_cross_attention(h, m, w_xq[l], w_xkv[l], w_xo[l], g_xq[l], g_xk[l])
        h = rms_norm(x, g_ffn[l])
        gate, up = jnp.split(h @ w_gu[l], 2, axis=-1)
        x = x + (jax.nn.silu(gate) * up) @ w_down[l]
    return x
```

```cpp
#include <hip/hip_runtime.h>
#include <stdint.h>

namespace nv {
constexpr int DM = 1024, B = 8, T = 2048, NMEM = 256, CH = 64;
constexpr int D_IN = 4696, D_FF = 2816;
constexpr float EPS = 1e-6f;
constexpr int O_GQKV = 0, O_GZ = 1536, O_GB = 2048, O_GA = 2052, O_DQ = 2056, O_DK = 2568, O_DV = 3080, O_IQ = 3592, O_IK = 4616, O_IW = 4680;

__device__ __forceinline__ float wsum(float v) {
#pragma unroll
  for (int o = 32; o > 0; o >>= 1) v += __shfl_xor(v, o);
  return v;
}
__device__ __forceinline__ float wmax(float v) {
#pragma unroll
  for (int o = 32; o > 0; o >>= 1) v = fmaxf(v, __shfl_xor(v, o));
  return v;
}
__device__ __forceinline__ float silu(float v) { return v / (1.f + expf(-v)); }

__global__ void k_rmsnorm(const float* x, const float* g, float* y, int rows, int dim) {
  int row = blockIdx.x * 4 + (threadIdx.x >> 6), lane = threadIdx.x & 63;
  if (row >= rows) return;
  const float* xr = x + (size_t)row * dim; float s = 0.f;
  for (int i = lane; i < dim; i += 64) s += xr[i] * xr[i];
  s = wsum(s); float r = rsqrtf(s / dim + EPS);
  for (int i = lane; i < dim; i += 64) y[(size_t)row * dim + i] = xr[i] * r * g[i];
}
__global__ void k_headnorm(float* x, int ld, int c0, int nh, int hd, const float* g, int rows) {
  int idx = blockIdx.x * 4 + (threadIdx.x >> 6), lane = threadIdx.x & 63;
  if (idx >= rows * nh) return;
  int row = idx / nh, h = idx % nh; float* p = x + (size_t)row * ld + c0 + h * hd; float s = 0.f;
  for (int i = lane; i < hd; i += 64) s += p[i] * p[i];
  s = wsum(s); float r = rsqrtf(s / hd + EPS);
  for (int i = lane; i < hd; i += 64) p[i] = p[i] * r * g[i];
}
__global__ void __launch_bounds__(256) k_gemm(const float* A, int lda, const float* Bm, int ldb, float* C, int ldc, int M, int N, int K, const float* R, int ldr) {
  __shared__ float As[16][65]; __shared__ float Bs[16][65];
  int tx = threadIdx.x & 15, ty = threadIdx.x >> 4; int m0 = blockIdx.y * 64, n0 = blockIdx.x * 64;
  float acc[4][4] = {};
  for (int k0 = 0; k0 < K; k0 += 16) {
    for (int i = threadIdx.x; i < 1024; i += 256) { int r = i >> 4, c = i & 15; As[c][r] = A[(size_t)(m0 + r) * lda + k0 + c]; }
    for (int i = threadIdx.x; i < 1024; i += 256) { int r = i >> 6, c = i & 63; Bs[r][c] = (n0 + c < N) ? Bm[(size_t)(k0 + r) * ldb + n0 + c] : 0.f; }
    __syncthreads();
#pragma unroll
    for (int k = 0; k < 16; ++k) { float a[4], b[4];
#pragma unroll
      for (int i = 0; i < 4; ++i) { a[i] = As[k][ty * 4 + i]; b[i] = Bs[k][tx * 4 + i]; }
#pragma unroll
      for (int i = 0; i < 4; ++i)
#pragma unroll
        for (int j = 0; j < 4; ++j) acc[i][j] += a[i] * b[j]; }
    __syncthreads();
  }
  for (int i = 0; i < 4; ++i) for (int j = 0; j < 4; ++j) { int r = m0 + ty * 4 + i, c = n0 + tx * 4 + j; if (c < N) { float v = acc[i][j]; if (R) v += R[(size_t)r * ldr + c]; C[(size_t)r * ldc + c] = v; } }
}
__global__ void k_gdn_conv(const float* proj, const float* cw, float* qkvc) {
  int idx = blockIdx.x * 256 + threadIdx.x; if (idx >= T * 1536) return; int t = idx / 1536, c = idx % 1536; float s = 0.f;
  for (int j = 0; j < 4; ++j) { int tt = t - 3 + j; if (tt >= 0) s += cw[j * 1536 + c] * proj[(size_t)tt * D_IN + O_GQKV + c]; }
  qkvc[idx] = silu(s);
}
__global__ void k_gdn_norm(float* qkvc, const float* proj, const float* a_log, const float* dt_bias, float* beta, float* gg) {
  int idx = blockIdx.x * 4 + (threadIdx.x >> 6), lane = threadIdx.x & 63; if (idx >= T * 4) return; int t = idx >> 2, h = idx & 3;
  float* q = qkvc + (size_t)t * 1536 + h * 128; float* k = q + 512;
  float q0 = q[lane], q1 = q[lane + 64], k0 = k[lane], k1 = k[lane + 64];
  float sq = wsum(q0 * q0 + q1 * q1), sk = wsum(k0 * k0 + k1 * k1);
  float rq = rsqrtf(sq + EPS) * 0.08838834764831845f, rk = rsqrtf(sk + EPS);
  q[lane] = q0 * rq; q[lane + 64] = q1 * rq; k[lane] = k0 * rk; k[lane + 64] = k1 * rk;
  if (lane == 0) { float bl = proj[(size_t)t * D_IN + O_GB + h], al = proj[(size_t)t * D_IN + O_GA + h] + dt_bias[h];
    beta[idx] = 1.f / (1.f + expf(-bl)); float sp = (al > 20.f) ? al : log1pf(expf(al)); gg[idx] = -expf(a_log[h]) * sp; }
}
__global__ void __launch_bounds__(128) k_gdn_scan(const float* qkvc, const float* beta, const float* gg, float* o) {
  __shared__ float ks[128], qs[128];
  int h = blockIdx.x, e = threadIdx.x; float S[128];
#pragma unroll
  for (int d = 0; d < 128; ++d) S[d] = 0.f;
  for (int t = 0; t < T; ++t) {
    const float* row = qkvc + (size_t)t * 1536;
    __syncthreads();
    qs[e] = row[h * 128 + e]; ks[e] = row[512 + h * 128 + e]; float v = row[1024 + h * 128 + e];
    float a = expf(gg[t * 4 + h]), b = beta[t * 4 + h];
    __syncthreads();
    float kS = 0.f;
#pragma unroll
    for (int d = 0; d < 128; ++d) kS += ks[d] * S[d];
    float vn = b * (v - a * kS); float oo = 0.f;
#pragma unroll
    for (int d = 0; d < 128; ++d) { S[d] = a * S[d] + ks[d] * vn; oo += qs[d] * S[d]; }
    o[(size_t)t * 512 + h * 128 + e] = oo;
  }
}
__global__ void k_gdn_out(const float* o, const float* proj, const float* g_out, float* ymix) {
  int idx = blockIdx.x * 4 + (threadIdx.x >> 6), lane = threadIdx.x & 63; if (idx >= T * 4) return; int t = idx >> 2, h = idx & 3;
  const float* p = o + (size_t)t * 512 + h * 128; float a0 = p[lane], a1 = p[lane + 64];
  float r = rsqrtf(wsum(a0 * a0 + a1 * a1) / 128.f + EPS);
  const float* z = proj + (size_t)t * D_IN + O_GZ + h * 128;
  ymix[(size_t)t * 1024 + h * 128 + lane] = a0 * r * g_out[lane] * silu(z[lane]);
  ymix[(size_t)t * 1024 + h * 128 + lane + 64] = a1 * r * g_out[lane + 64] * silu(z[lane + 64]);
}
__global__ void k_dsa_norm(const float* proj, const float* gq, const float* gk, float* qn, float* kn) {
  int idx = blockIdx.x * 4 + (threadIdx.x >> 6), lane = threadIdx.x & 63; if (idx >= T * 8) return; int t = idx >> 3, h = idx & 7;
  float q = proj[(size_t)t * D_IN + O_DQ + h * 64 + lane], k = proj[(size_t)t * D_IN + O_DK + h * 64 + lane];
  float rq = rsqrtf(wsum(q * q) / 64.f + EPS), rk = rsqrtf(wsum(k * k) / 64.f + EPS);
  qn[(size_t)t * 512 + h * 64 + lane] = q * rq * gq[lane]; kn[(size_t)t * 512 + h * 64 + lane] = k * rk * gk[lane];
}
__global__ void __launch_bounds__(256) k_dsa_score(const float* proj, float* scores) {
  int kc = blockIdx.x, qc = blockIdx.y; if (kc > qc) return;
  __shared__ float qs[64][65]; __shared__ float ksh[64][65];
  int tx = threadIdx.x & 15, ty = threadIdx.x >> 4; float acc[4][4] = {};
  for (int i = threadIdx.x; i < 4096; i += 256) { int r = i >> 6, c = i & 63; ksh[c][r] = proj[(size_t)(kc * 64 + r) * D_IN + O_IK + c]; }
  for (int h = 0; h < 16; ++h) {
    __syncthreads();
    for (int i = threadIdx.x; i < 4096; i += 256) { int r = i >> 6, c = i & 63; qs[c][r] = proj[(size_t)(qc * 64 + r) * D_IN + O_IQ + h * 64 + c]; }
    __syncthreads();
    float d[4][4] = {};
#pragma unroll 8
    for (int k = 0; k < 64; ++k) { float a[4], b[4];
#pragma unroll
      for (int i = 0; i < 4; ++i) { a[i] = qs[k][ty * 4 + i]; b[i] = ksh[k][tx * 4 + i]; }
#pragma unroll
      for (int i = 0; i < 4; ++i)
#pragma unroll
        for (int j = 0; j < 4; ++j) d[i][j] += a[i] * b[j]; }
#pragma unroll
    for (int i = 0; i < 4; ++i) { float w = proj[(size_t)(qc * 64 + ty * 4 + i) * D_IN + O_IW + h] * 0.25f;
#pragma unroll
      for (int j = 0; j < 4; ++j) acc[i][j] += w * fmaxf(d[i][j] * 0.125f, 0.f); }
  }
  for (int i = 0; i < 4; ++i) for (int j = 0; j < 4; ++j) scores[(size_t)(qc * 64 + ty * 4 + i) * 2048 + kc * 64 + tx * 4 + j] = acc[i][j];
}
__device__ __forceinline__ unsigned ord(float f) { unsigned u = __float_as_uint(f); return (u & 0x80000000u) ? ~u : (u | 0x80000000u); }
__global__ void __launch_bounds__(256) k_dsa_select(const float* scores, unsigned char* sel) {
  int q = blockIdx.x * 4 + (threadIdx.x >> 6), lane = threadIdx.x & 63; if (q >= T) return;
  int n = (q / 64 + 1) * 64; unsigned char* so = sel + (size_t)q * 2048;
  if (n <= 256) { for (int s = lane; s < n; s += 64) so[s] = 1; return; }
  unsigned v[32];
#pragma unroll
  for (int i = 0; i < 32; ++i) { int s = lane + 64 * i; v[i] = (s < n) ? ord(scores[(size_t)q * 2048 + s]) : 0u; }
  unsigned thr = 0;
  for (int bit = 31; bit >= 0; --bit) { unsigned cand = thr | (1u << bit); int c = 0;
#pragma unroll
    for (int i = 0; i < 32; ++i) c += (v[i] >= cand) ? 1 : 0;
    c = (int)wsum((float)c);
    if (c >= 256) thr = cand; }
  int cgt = 0;
#pragma unroll
  for (int i = 0; i < 32; ++i) cgt += (v[i] > thr) ? 1 : 0;
  cgt = (int)wsum((float)cgt); int need = 256 - cgt;
#pragma unroll
  for (int i = 0; i < 32; ++i) { int s = lane + 64 * i; bool eq = (v[i] == thr) && (s < n); unsigned long long m = __ballot(eq);
    int before = __popcll(m & ((1ull << lane) - 1ull)); bool take = (v[i] > thr) || (eq && before < need);
    need -= __popcll(m); if (need < 0) need = 0;
    if (s < n) so[s] = take ? 1 : 0; }
}
__global__ void __launch_bounds__(256) k_dsa_attn(const float* qn, const float* kn, const float* proj, const unsigned char* sel, float* ymix) {
  extern __shared__ float lg[];
  float* qs = lg + 8 * 2048; __shared__ float red[8][4]; __shared__ float hm[8], hs[8];
  int q = blockIdx.x, n = (q / 64 + 1) * 64, tid = threadIdx.x, lane = tid & 63, w = tid >> 6;
  for (int i = tid; i < 512; i += 256) qs[i] = qn[(size_t)q * 512 + i];
  __syncthreads();
  for (int s = tid; s < n; s += 256) { bool on = sel[(size_t)q * 2048 + s] != 0; float dist = fabsf((float)(q - s));
    for (int h = 0; h < 8; ++h) { float l = -INFINITY;
      if (on) { float d = 0.f; const float* kp = kn + (size_t)s * 512 + h * 64; for (int i = 0; i < 64; ++i) d += qs[h * 64 + i] * kp[i]; l = d * 0.125f - exp2f(-(float)(h + 1)) * dist; }
      lg[h * 2048 + s] = l; } }
  __syncthreads();
  for (int h = 0; h < 8; ++h) { float m = -INFINITY; for (int s = tid; s < n; s += 256) m = fmaxf(m, lg[h * 2048 + s]); m = wmax(m); if (lane == 0) red[h][w] = m; }
  __syncthreads();
  if (tid < 8) hm[tid] = fmaxf(fmaxf(red[tid][0], red[tid][1]), fmaxf(red[tid][2], red[tid][3]));
  __syncthreads();
  for (int h = 0; h < 8; ++h) { float sm = 0.f; for (int s = tid; s < n; s += 256) { float p = expf(lg[h * 2048 + s] - hm[h]); lg[h * 2048 + s] = p; sm += p; } sm = wsum(sm); if (lane == 0) red[h][w] = sm; }
  __syncthreads();
  if (tid < 8) hs[tid] = red[tid][0] + red[tid][1] + red[tid][2] + red[tid][3];
  __syncthreads();
  { int h = tid >> 5, d0 = (tid & 31) * 2; float a0 = 0.f, a1 = 0.f;
    for (int s = 0; s < n; ++s) { float p = lg[h * 2048 + s]; if (p != 0.f) { const float* vp = proj + (size_t)s * D_IN + O_DV + h * 64 + d0; a0 += p * vp[0]; a1 += p * vp[1]; } }
    float inv = 1.f / hs[h]; ymix[(size_t)q * 1024 + 512 + h * 64 + d0] = a0 * inv; ymix[(size_t)q * 1024 + 512 + h * 64 + d0 + 1] = a1 * inv; }
}
__global__ void __launch_bounds__(256) k_xattn(const float* xq, const float* kv, float* xo) {
  __shared__ float qs[512], p[4][256], red[4][4], hm[4], hs[4];
  int t = blockIdx.x, tid = threadIdx.x, lane = tid & 63, w = tid >> 6;
  qs[tid] = xq[(size_t)t * 512 + tid]; qs[tid + 256] = xq[(size_t)t * 512 + tid + 256];
  __syncthreads();
  for (int h = 0; h < 4; ++h) { float d = 0.f; const float* kp = kv + (size_t)tid * 1024 + h * 128; for (int i = 0; i < 128; ++i) d += qs[h * 128 + i] * kp[i];
    d *= 0.08838834764831845f; p[h][tid] = d; float m = wmax(d); if (lane == 0) red[h][w] = m; }
  __syncthreads();
  if (tid < 4) hm[tid] = fmaxf(fmaxf(red[tid][0], red[tid][1]), fmaxf(red[tid][2], red[tid][3]));
  __syncthreads();
  for (int h = 0; h < 4; ++h) { float e = expf(p[h][tid] - hm[h]); p[h][tid] = e; float s = wsum(e); if (lane == 0) red[h][w] = s; }
  __syncthreads();
  if (tid < 4) hs[tid] = red[tid][0] + red[tid][1] + red[tid][2] + red[tid][3];
  __syncthreads();
  { int h = tid >> 6, d0 = (tid & 63) * 2; float a0 = 0.f, a1 = 0.f;
    for (int m = 0; m < 256; ++m) { float pp = p[h][m]; const float* vp = kv + (size_t)m * 1024 + 512 + h * 128 + d0; a0 += pp * vp[0]; a1 += pp * vp[1]; }
    float inv = 1.f / hs[h]; xo[(size_t)t * 512 + h * 128 + d0] = a0 * inv; xo[(size_t)t * 512 + h * 128 + d0 + 1] = a1 * inv; }
}
__global__ void k_swiglu(const float* gu, float* act) {
  int idx = blockIdx.x * 256 + threadIdx.x; if (idx >= T * D_FF) return; int t = idx / D_FF, c = idx % D_FF;
  float g = gu[(size_t)t * 2 * D_FF + c], u = gu[(size_t)t * 2 * D_FF + D_FF + c]; act[idx] = silu(g) * u;
}
static void gemm(hipStream_t st, const float* A, int lda, const float* Bm, int ldb, float* C, int ldc, int M, int N, int K, const float* R, int ldr) {
  dim3 g((N + 63) / 64, M / 64); k_gemm<<<g, 256, 0, st>>>(A, lda, Bm, ldb, C, ldc, M, N, K, R, ldr);
}
}

extern "C" void kernel_launch(void* const* d_in, const int* in_sizes, int n_in, void* d_out, int out_size, void* d_ws, size_t ws_size, hipStream_t stream) {
  using namespace nv;
  const float* x = (const float*)d_in[0]; const float* mem = (const float*)d_in[1]; const float* g_mix = (const float*)d_in[2]; const float* w_in = (const float*)d_in[3];
  const float* conv_w = (const float*)d_in[4]; const float* a_log = (const float*)d_in[5]; const float* dt_bias = (const float*)d_in[6]; const float* g_gdn_out = (const float*)d_in[7];
  const float* g_q_dsa = (const float*)d_in[8]; const float* g_k_dsa = (const float*)d_in[9]; const float* w_out = (const float*)d_in[10]; const float* g_xattn = (const float*)d_in[11];
  const float* g_mem = (const float*)d_in[12]; const float* w_xq = (const float*)d_in[13]; const float* w_xkv = (const float*)d_in[14]; const float* g_xq = (const float*)d_in[15];
  const float* g_xk = (const float*)d_in[16]; const float* w_xo = (const float*)d_in[17]; const float* g_ffn = (const float*)d_in[18]; const float* w_gu = (const float*)d_in[19];
  const float* w_down = (const float*)d_in[20];
  float* out = (float*)d_out;
  float* ws = (float*)d_ws; size_t off = 0;
  auto take = [&](size_t n) { float* p = ws + off; off += (n + 63) & ~(size_t)63; return p; };
  float* hbuf = take((size_t)T * DM);
  float* proj = take((size_t)T * D_IN);
  float* qkvc = take((size_t)T * 1536);
  float* beta = take(T * 4); float* gg = take(T * 4);
  float* ogdn = take((size_t)T * 512);
  float* ymix = take((size_t)T * 1024);
  float* qn = take((size_t)T * 512); float* kn = take((size_t)T * 512);
  float* scores = take((size_t)T * 2048);
  unsigned char* sel = (unsigned char*)take((size_t)T * 2048 / 4);
  float* xq = take((size_t)T * 512); float* xo = take((size_t)T * 512);
  float* memn = take((size_t)NMEM * DM); float* kv = take((size_t)NMEM * 1024);
  float* gu = take((size_t)T * 2 * D_FF); float* act = take((size_t)T * D_FF);
  (void)hipFuncSetAttribute((const void*)k_dsa_attn, hipFuncAttributeMaxDynamicSharedMemorySize, (8 * 2048 + 512) * 4);
  for (int b = 0; b < B; ++b) {
    const float* xb = x + (size_t)b * T * DM; float* ob = out + (size_t)b * T * DM; const float* memb = mem + (size_t)b * NMEM * DM;
    k_rmsnorm<<<T / 4, 256, 0, stream>>>(xb, g_mix, hbuf, T, DM);
    gemm(stream, hbuf, DM, w_in, D_IN, proj, D_IN, T, D_IN, DM, nullptr, 0);
    k_gdn_conv<<<(T * 1536 + 255) / 256, 256, 0, stream>>>(proj, conv_w, qkvc);
    k_gdn_norm<<<T, 256, 0, stream>>>(qkvc, proj, a_log, dt_bias, beta, gg);
    k_gdn_scan<<<4, 128, 0, stream>>>(qkvc, beta, gg, ogdn);
    k_gdn_out<<<T, 256, 0, stream>>>(ogdn, proj, g_gdn_out, ymix);
    k_dsa_norm<<<T * 2, 256, 0, stream>>>(proj, g_q_dsa, g_k_dsa, qn, kn);
    k_dsa_score<<<dim3(32, 32), 256, 0, stream>>>(proj, scores);
    k_dsa_select<<<T / 4, 256, 0, stream>>>(scores, sel);
    k_dsa_attn<<<T, 256, (8 * 2048 + 512) * 4, stream>>>(qn, kn, proj, sel, ymix);
    gemm(stream, ymix, 1024, w_out, DM, ob, DM, T, DM, 1024, xb, DM);
    k_rmsnorm<<<T / 4, 256, 0, stream>>>(ob, g_xattn, hbuf, T, DM);
    gemm(stream, hbuf, DM, w_xq, 512, xq, 512, T, 512, DM, nullptr, 0);
    k_headnorm<<<T, 256, 0, stream>>>(xq, 512, 0, 4, 128, g_xq, T);
    k_rmsnorm<<<NMEM / 4, 256, 0, stream>>>(memb, g_mem, memn, NMEM, DM);
    gemm(stream, memn, DM, w_xkv, 1024, kv, 1024, NMEM, 1024, DM, nullptr, 0);
    k_headnorm<<<NMEM, 256, 0, stream>>>(kv, 1024, 0, 4, 128, g_xk, NMEM);
    k_xattn<<<T, 256, 0, stream>>>(xq, kv, xo);
    gemm(stream, xo, 512, w_xo, DM, ob, DM, T, DM, 512, ob, DM);
    k_rmsnorm<<<T / 4, 256, 0, stream>>>(ob, g_ffn, hbuf, T, DM);
    gemm(stream, hbuf, DM, w_gu, 2 * D_FF, gu, 2 * D_FF, T, 2 * D_FF, DM, nullptr, 0);
    k_swiglu<<<(T * D_FF + 255) / 256, 256, 0, stream>>>(gu, act);
    gemm(stream, act, D_FF, w_down, DM, ob, DM, T, DM, D_FF, ob, DM);
  }
}
```

```cpp
#include <hip/hip_runtime.h>
#include <cstdio>
#include <cstdint>
namespace pg8 {
#define PG8_LAS __attribute__((address_space(3)))
typedef unsigned short bf16_t;
typedef short bf16x8 __attribute__((ext_vector_type(8)));
typedef float f32x4 __attribute__((ext_vector_type(4)));
typedef unsigned u32x4 __attribute__((ext_vector_type(4)));
constexpr int BM = 256, BK = 64, HALF = 128, HTB = HALF * BK * 2  , STAGE_BYTES = 8 * HTB, NXCD = 8, WGM = 8;

__host__ __device__ __forceinline__ int lds_byte(int r, int c) { const int st = (r >> 4) * 2 + (c >> 5), rr = r & 15, cc = c & 31, ob = rr * 64 + cc * 2; return st * 1024 + (ob ^ (((ob >> 9) & 1) << 5)); }
__host__ __device__ __forceinline__ void stage_rc(int b, int& R, int& C) { const int st = b / 1024, sb = b % 1024, swz = sb ^ (((sb >> 9) & 1) << 5); R = (st >> 1) * 16 + swz / 64; C = (st & 1) * 32 + (swz % 64) / 2; }
__host__ __device__ __forceinline__ int perm32(int rho) { const int n = rho >> 4, i = rho & 15; return 8 * (i >> 2) + 4 * n + (i & 3); }

struct Unit { int pm, pn; };
struct Gemm { const bf16_t* A; const bf16_t* Bt; int M, N, K; };

struct StaticOrder {
    int nM, nN, nwg, G, c;
    __host__ __device__ void init(int M, int N, int G_, int c_) { nM = M / BM; nN = N / BM; nwg = nM * nN; G = G_; c = c_; }
    __host__ __device__ bool next(int i, Unit& u) const {
        const long L = (long)i * G + c; if (L >= nwg) return false;
        int wgid = (int)L; { const int q = nwg / NXCD, r = nwg % NXCD, xcd = wgid % NXCD, off = wgid / NXCD; wgid = (xcd < r ? xcd * (q + 1) : r * (q + 1) + (xcd - r) * q) + off; }
        const int nig = WGM * nN, gid = wgid / nig, fm = gid * WGM, gsz = (nM - fm) < WGM ? (nM - fm) : WGM;
        u.pm = fm + ((wgid % nig) % gsz); u.pn = (wgid % nig) / gsz; return true;
    }
    __device__ __forceinline__ void a_ready(const Unit&) const {}
    __device__ __forceinline__ void done(const Unit&) const {}
};

__device__ __forceinline__ unsigned cvt_pk_bf16(float lo, float hi) { unsigned r; asm volatile("v_cvt_pk_bf16_f32 %0, %1, %2" : "=v"(r) : "v"(lo), "v"(hi)); return r; }
constexpr float RMS_EPS = 1e-6f;
struct EpiScale {
    static constexpr bool PERM = true, AFTER_DRAIN = false;
    bf16_t* O; int ldc; const float* ssq; int nvalid; int wt_bytes;
    __device__ __forceinline__ void operator()(const f32x4 (&acc)[2][2][4][2], const Unit& u, int wr, int wc, int fr, int fq) const {
        const int row0 = u.pm * BM + wr * 64 + fr, col0 = u.pn * BM + wc * 32 + 8 * fq;
        const __amdgpu_buffer_rsrc_t rsrc = __builtin_amdgcn_make_buffer_rsrc(O, 0, wt_bytes, 0x00020000);
#pragma unroll
        for (int ai = 0; ai < 2; ++ai)
#pragma unroll
            for (int m = 0; m < 4; ++m) { const int row = row0 + ai * HALF + m * 16; const float rs = __builtin_amdgcn_rsqf(ssq[row] * (1.0f / 1024.0f) + RMS_EPS);
                bf16_t* rowp = O + (size_t)row * ldc + col0;
#pragma unroll
                for (int bj = 0; bj < 2; ++bj) if (col0 + bj * HALF < nvalid) { const f32x4 v0 = acc[ai][bj][m][0] * rs, v1 = acc[ai][bj][m][1] * rs;
                    u32x4 w; w.x = cvt_pk_bf16(v0[0], v0[1]); w.y = cvt_pk_bf16(v0[2], v0[3]); w.z = cvt_pk_bf16(v1[0], v1[1]); w.w = cvt_pk_bf16(v1[2], v1[3]);
                    if (wt_bytes > 0) __builtin_amdgcn_raw_buffer_store_b128(w, rsrc, (int)(((size_t)row * ldc + col0 + bj * HALF) * 2), 0, 16);
                    else *(u32x4*)(rowp + bj * HALF) = w; } }
    }
};
struct EpiScaleCol {
    static constexpr bool PERM = true, AFTER_DRAIN = false;
    bf16_t* O; int ldc; const float* ssq;
    __device__ __forceinline__ void operator()(const f32x4 (&acc)[2][2][4][2], const Unit& u, int wr, int wc, int fr, int fq) const {
        const int row0 = u.pm * BM + wr * 64 + fr, col0 = u.pn * BM + wc * 32 + 8 * fq;
#pragma unroll
        for (int bj = 0; bj < 2; ++bj) { f32x4 s0 = *(const f32x4*)(ssq + col0 + bj * HALF), s1 = *(const f32x4*)(ssq + col0 + bj * HALF + 4);
#pragma unroll
            for (int e = 0; e < 4; ++e) { s0[e] = __builtin_amdgcn_rsqf(s0[e] * (1.0f / 1024.0f) + RMS_EPS); s1[e] = __builtin_amdgcn_rsqf(s1[e] * (1.0f / 1024.0f) + RMS_EPS); }
#pragma unroll
            for (int ai = 0; ai < 2; ++ai)
#pragma unroll
                for (int m = 0; m < 4; ++m) { const int row = row0 + ai * HALF + m * 16; const f32x4 v0 = acc[ai][bj][m][0] * s0, v1 = acc[ai][bj][m][1] * s1;
                    u32x4 w; w.x = cvt_pk_bf16(v0[0], v0[1]); w.y = cvt_pk_bf16(v0[2], v0[3]); w.z = cvt_pk_bf16(v1[0], v1[1]); w.w = cvt_pk_bf16(v1[2], v1[3]);
                    *(u32x4*)(O + (size_t)row * ldc + col0 + bj * HALF) = w; } }
    }
};
template <bool BASE_BF16, bool OUT_F32, bool OUT_BF16> struct EpiRes {
    static constexpr bool PERM = true, AFTER_DRAIN = false;
    const void* base; float* out; bf16_t* xb; float* ssq; int ldc;
    __device__ __forceinline__ void operator()(const f32x4 (&acc)[2][2][4][2], const Unit& u, int wr, int wc, int fr, int fq) const {
        const int row0 = u.pm * BM + wr * 64 + fr, col0 = u.pn * BM + wc * 32 + 8 * fq;
#pragma unroll
        for (int ai = 0; ai < 2; ++ai)
#pragma unroll
            for (int m = 0; m < 4; ++m) { const int row = row0 + ai * HALF + m * 16; const size_t off = (size_t)row * ldc + col0; float part = 0.f;
#pragma unroll
                for (int bj = 0; bj < 2; ++bj) { f32x4 b0, b1;
                    if (BASE_BF16) { const u32x4 r = *(const u32x4*)((const bf16_t*)base + off + bj * HALF);
                        b0 = (f32x4){__builtin_bit_cast(float, r.x << 16), __builtin_bit_cast(float, r.x & 0xffff0000u), __builtin_bit_cast(float, r.y << 16), __builtin_bit_cast(float, r.y & 0xffff0000u)};
                        b1 = (f32x4){__builtin_bit_cast(float, r.z << 16), __builtin_bit_cast(float, r.z & 0xffff0000u), __builtin_bit_cast(float, r.w << 16), __builtin_bit_cast(float, r.w & 0xffff0000u)}; }
                    else { b0 = *(const f32x4*)((const float*)base + off + bj * HALF); b1 = *(const f32x4*)((const float*)base + off + bj * HALF + 4); }
                    const f32x4 v0 = acc[ai][bj][m][0] + b0, v1 = acc[ai][bj][m][1] + b1;
                    if (OUT_F32) { *(f32x4*)(out + off + bj * HALF) = v0; *(f32x4*)(out + off + bj * HALF + 4) = v1; }
                    if (OUT_BF16) { u32x4 w; w.x = cvt_pk_bf16(v0[0], v0[1]); w.y = cvt_pk_bf16(v0[2], v0[3]); w.z = cvt_pk_bf16(v1[0], v1[1]); w.w = cvt_pk_bf16(v1[2], v1[3]); *(u32x4*)(xb + off + bj * HALF) = w; }
                    part += (v0[0] * v0[0] + v0[1] * v0[1]) + (v0[2] * v0[2] + v0[3] * v0[3]) + (v1[0] * v1[0] + v1[1] * v1[1]) + (v1[2] * v1[2] + v1[3] * v1[3]); }
                if (ssq) { part += __shfl_xor(part, 16); part += __shfl_xor(part, 32); if (fq == 0) atomicAdd(ssq + row, part); } }
    }
};
struct EpiSwiglu {
    static constexpr bool PERM = true, AFTER_DRAIN = false;
    bf16_t* O; int ldc; const float* ssq; int wt_bytes;
    __device__ __forceinline__ void operator()(const f32x4 (&acc)[2][2][4][2], const Unit& u, int wr, int wc, int fr, int fq) const {
        const int row0 = u.pm * BM + wr * 64 + fr, col0 = u.pn * HALF + wc * 32 + 8 * fq;
        const __amdgpu_buffer_rsrc_t rsrc = __builtin_amdgcn_make_buffer_rsrc(O, 0, wt_bytes, 0x00020000);
#pragma unroll
        for (int ai = 0; ai < 2; ++ai)
#pragma unroll
            for (int m = 0; m < 4; ++m) { const int row = row0 + ai * HALF + m * 16; const float rs = __builtin_amdgcn_rsqf(ssq[row] * (1.0f / 1024.0f) + RMS_EPS);
                float a[8];
#pragma unroll
                for (int n = 0; n < 2; ++n)
#pragma unroll
                    for (int e = 0; e < 4; ++e) { const float g = acc[ai][0][m][n][e] * rs, up = acc[ai][1][m][n][e] * rs;
                        a[n * 4 + e] = g * __builtin_amdgcn_rcpf(1.0f + __builtin_amdgcn_exp2f(g * -1.4426950408889634f)) * up; }
                u32x4 w; w.x = cvt_pk_bf16(a[0], a[1]); w.y = cvt_pk_bf16(a[2], a[3]); w.z = cvt_pk_bf16(a[4], a[5]); w.w = cvt_pk_bf16(a[6], a[7]);
                if (wt_bytes > 0) __builtin_amdgcn_raw_buffer_store_b128(w, rsrc, (int)(((size_t)row * ldc + col0) * 2), 0, 16);
                else *(u32x4*)(O + (size_t)row * ldc + col0) = w; }
    }
};
template <class Epi, class Sched, bool ALIGN_EPI = false, bool SP2 = false>
__device__ __forceinline__ void gemm_phase(PG8_LAS unsigned char* lds, const Gemm g, const Sched& S, const Epi& E) {
    const int tid = threadIdx.x, wid = __builtin_amdgcn_readfirstlane(tid >> 6), lane = tid & 63, wr = wid >> 2, wc = wid & 3, fr = lane & 15, fq = lane >> 4;
    const int K = g.K, nt = K / BK;
    unsigned voffA[2], voffB[2];
#pragma unroll
    for (int i = 0; i < 2; ++i) { int R, C; stage_rc(tid * 16 + i * 8192, R, C); const int Rb = Epi::PERM ? ((R & ~31) + perm32(R & 31)) : R;
        voffA[i] = (unsigned)(R * K + C) * 2u; voffB[i] = (unsigned)(Rb * K + C) * 2u; }
    const size_t kstep = (size_t)(BK * 2);
    const size_t hstep = (size_t)HALF * K * 2;
    const size_t tstep = 2 * hstep;
    const unsigned ldsw = (unsigned)wid * 1024u;
    const int aoff = lds_byte(wr * 64 + fr, fq * 8), boff = lds_byte(wc * 32 + fr, fq * 8);
#define PG8_SA(b, h) (((b) * 2 + (h)) * HTB)
#define PG8_SB(b, h) ((4 + (b) * 2 + (h)) * HTB)
#define PG8_STAGE(bufoff, gbase, voff) do { _Pragma("unroll") for (int _i = 0; _i < 2; ++_i) \
        __builtin_amdgcn_global_load_lds((const unsigned*)((const char*)(gbase) + (voff)[_i]), (PG8_LAS unsigned*)(lds + (bufoff) + ldsw + _i * 8192), 16, 0, 0); } while (0)
#define PG8_LDA(dst, b, h) do { _Pragma("unroll") for (int m = 0; m < 4; ++m) _Pragma("unroll") for (int k = 0; k < 2; ++k) dst[m][k] = *(const PG8_LAS bf16x8*)(lds + PG8_SA(b, h) + aoff + m * 2048 + k * 1024); } while (0)
#define PG8_LDB(dst, b, h) do { _Pragma("unroll") for (int n = 0; n < 2; ++n) _Pragma("unroll") for (int k = 0; k < 2; ++k) dst[n][k] = *(const PG8_LAS bf16x8*)(lds + PG8_SB(b, h) + boff + n * 2048 + k * 1024); } while (0)
#define PG8_MMA(ai, bj, At, Bt) do { __builtin_amdgcn_s_setprio(1); _Pragma("unroll") for (int m = 0; m < 4; ++m) _Pragma("unroll") for (int n = 0; n < 2; ++n) _Pragma("unroll") for (int k = 0; k < 2; ++k) \
        acc[ai][bj][m][n] = __builtin_amdgcn_mfma_f32_16x16x32_bf16(Bt[n][k], At[m][k], acc[ai][bj][m][n], 0, 0, 0); __builtin_amdgcn_s_setprio(0); } while (0)
#define PG8_WAIT_V(n) asm volatile("s_waitcnt vmcnt(" #n ")" ::: "memory")
#define PG8_WAIT_L(n) asm volatile("s_waitcnt lgkmcnt(" #n ")" ::: "memory")
#define PG8_BAR __builtin_amdgcn_s_barrier()
#define PG8_SCHED __builtin_amdgcn_sched_barrier(0)
    Unit cur, nxt; int ui = 0;
    if (!S.next(0, cur)) return;
    f32x4 acc[2][2][4][2];
#pragma unroll
    for (int a = 0; a < 2; ++a)
#pragma unroll
        for (int b = 0; b < 2; ++b)
#pragma unroll
            for (int m = 0; m < 4; ++m)
#pragma unroll
                for (int n = 0; n < 2; ++n) acc[a][b][m][n] = (f32x4){0.f, 0.f, 0.f, 0.f};
    bf16x8 At[4][2], B0[2][2], B1[2][2];
    const char* cA = (const char*)g.A + (size_t)cur.pm * tstep; const char* cB = (const char*)g.Bt + (size_t)cur.pn * tstep;
    S.a_ready(cur);
    if constexpr (SP2) {
        PG8_STAGE(PG8_SB(0, 0), cB, voffB); PG8_STAGE(PG8_SB(0, 1), cB + hstep, voffB); PG8_STAGE(PG8_SA(0, 0), cA, voffA); PG8_STAGE(PG8_SA(0, 1), cA + hstep, voffA);
        if (wr == 1) PG8_BAR;
        PG8_WAIT_V(2); PG8_BAR;
        PG8_STAGE(PG8_SB(1, 0), cB + kstep, voffB); PG8_STAGE(PG8_SA(1, 0), cA + kstep, voffA); PG8_STAGE(PG8_SB(1, 1), cB + hstep + kstep, voffB);
        PG8_WAIT_V(6); PG8_BAR;
    } else {
        PG8_STAGE(PG8_SB(0, 0), cB, voffB); PG8_STAGE(PG8_SA(0, 0), cA, voffA); PG8_STAGE(PG8_SB(0, 1), cB + hstep, voffB); PG8_STAGE(PG8_SA(0, 1), cA + hstep, voffA);
        if (wr == 1) PG8_BAR;
        PG8_WAIT_V(4); PG8_BAR;
        PG8_STAGE(PG8_SB(1, 0), cB + kstep, voffB); PG8_STAGE(PG8_SA(1, 0), cA + kstep, voffA); PG8_STAGE(PG8_SB(1, 1), cB + hstep + kstep, voffB);
        PG8_WAIT_V(6); PG8_BAR;
    }
    for (;;) {
        const bool has_next = S.next(ui + 1, nxt);
        const char* nA = has_next ? (const char*)g.A + (size_t)nxt.pm * tstep : cA; const char* nB = has_next ? (const char*)g.Bt + (size_t)nxt.pn * tstep : cB;
        for (int t = 0; t < nt; t += 2) {
            const bool last = (t == nt - 2);
            const char* a1 = cA + (size_t)(t + 1) * kstep;
            const char* a2 = last ? nA : cA + (size_t)(t + 2) * kstep; const char* b2 = last ? nB : cB + (size_t)(t + 2) * kstep;
            const char* a3 = a2 + kstep; const char* b3 = b2 + kstep;
            if (last && has_next) S.a_ready(nxt);
            if constexpr (SP2) {
            PG8_LDB(B0, 0, 0); PG8_LDB(B1, 0, 1); PG8_SCHED; PG8_LDA(At, 0, 0); PG8_STAGE(PG8_SA(1, 1), a1 + hstep, voffA);
            PG8_WAIT_V(8); PG8_WAIT_L(0); PG8_BAR; PG8_MMA(0, 0, At, B0); PG8_MMA(0, 1, At, B1); PG8_BAR; PG8_SCHED;
            PG8_LDA(At, 0, 1); PG8_STAGE(PG8_SB(0, 0), b2, voffB); PG8_STAGE(PG8_SB(0, 1), b2 + hstep, voffB); PG8_STAGE(PG8_SA(0, 0), a2, voffA);
            PG8_WAIT_V(8); PG8_WAIT_L(0); PG8_BAR; PG8_MMA(1, 0, At, B0); PG8_MMA(1, 1, At, B1); PG8_BAR; PG8_SCHED;
            PG8_LDB(B0, 1, 0); PG8_LDB(B1, 1, 1); PG8_SCHED; PG8_LDA(At, 1, 0); PG8_STAGE(PG8_SA(0, 1), a2 + hstep, voffA);
            PG8_WAIT_V(8); PG8_WAIT_L(0); PG8_BAR; PG8_MMA(0, 0, At, B0); PG8_MMA(0, 1, At, B1); PG8_BAR; PG8_SCHED;
            PG8_LDA(At, 1, 1); PG8_STAGE(PG8_SB(1, 0), b3, voffB); PG8_STAGE(PG8_SB(1, 1), b3 + hstep, voffB); PG8_STAGE(PG8_SA(1, 0), a3, voffA);
            PG8_WAIT_V(8); PG8_WAIT_L(0); PG8_BAR; PG8_MMA(1, 0, At, B0); PG8_MMA(1, 1, At, B1); PG8_BAR; PG8_SCHED;
            } else {
            PG8_LDB(B0, 0, 0); PG8_SCHED; PG8_LDA(At, 0, 0); PG8_STAGE(PG8_SA(1, 1), a1 + hstep, voffA);
            PG8_WAIT_L(8); PG8_BAR; PG8_WAIT_L(0); PG8_MMA(0, 0, At, B0); PG8_BAR; PG8_SCHED;
            PG8_LDB(B1, 0, 1); PG8_STAGE(PG8_SB(0, 0), b2, voffB);
            PG8_BAR; PG8_WAIT_L(0); PG8_MMA(0, 1, At, B1); PG8_BAR;
            PG8_LDA(At, 0, 1); PG8_STAGE(PG8_SA(0, 0), a2, voffA);
            PG8_BAR; PG8_WAIT_L(0); PG8_MMA(1, 0, At, B0); PG8_BAR; PG8_SCHED;
            PG8_STAGE(PG8_SB(0, 1), b2 + hstep, voffB);
            PG8_WAIT_V(6); PG8_BAR; PG8_MMA(1, 1, At, B1); PG8_BAR;
            PG8_LDB(B0, 1, 0); PG8_SCHED; PG8_LDA(At, 1, 0); PG8_STAGE(PG8_SA(0, 1), a2 + hstep, voffA);
            PG8_WAIT_L(8); PG8_BAR; PG8_WAIT_L(0); PG8_MMA(0, 0, At, B0); PG8_BAR; PG8_SCHED;
            PG8_LDB(B1, 1, 1); PG8_STAGE(PG8_SB(1, 0), b3, voffB);
            PG8_BAR; PG8_WAIT_L(0); PG8_MMA(0, 1, At, B1); PG8_BAR;
            PG8_LDA(At, 1, 1); PG8_STAGE(PG8_SA(1, 0), a3, voffA);
            PG8_BAR; PG8_WAIT_L(0); PG8_MMA(1, 0, At, B0); PG8_BAR; PG8_SCHED;
            PG8_STAGE(PG8_SB(1, 1), b3 + hstep, voffB);
            PG8_WAIT_V(6); PG8_BAR; PG8_MMA(1, 1, At, B1); PG8_BAR;
            }
        }
        if constexpr (ALIGN_EPI) { if (wr == 0) PG8_BAR; }
        if constexpr (!Epi::AFTER_DRAIN) { E(acc, cur, wr, wc, fr, fq); S.done(cur); }
        if (!has_next) break;
#pragma unroll
        for (int a = 0; a < 2; ++a)
#pragma unroll
            for (int b = 0; b < 2; ++b)
#pragma unroll
                for (int m = 0; m < 4; ++m)
#pragma unroll
                    for (int n = 0; n < 2; ++n) acc[a][b][m][n] = (f32x4){0.f, 0.f, 0.f, 0.f};
        cur = nxt; cA = nA; cB = nB; ++ui;
        if constexpr (ALIGN_EPI) { if (wr == 1) PG8_BAR; }
    }
    PG8_WAIT_V(0);
    if constexpr (!ALIGN_EPI) { if (wr == 0) PG8_BAR; }
    PG8_BAR;
    if constexpr (Epi::AFTER_DRAIN) { E.fused(acc, cur, wr, wc, fr, fq, lds, wid, lane); S.done(cur); }
#undef PG8_SA
#undef PG8_SB
#undef PG8_STAGE
#undef PG8_LDA
#undef PG8_LDB
#undef PG8_MMA
#undef PG8_WAIT_V
#undef PG8_WAIT_L
#undef PG8_BAR
#undef PG8_SCHED
}
}
namespace mk {
#define GAS __attribute__((address_space(1)))
#define LAS __attribute__((address_space(3)))
typedef unsigned short bf16;
typedef unsigned v4u __attribute__((ext_vector_type(4)));
typedef float f32x4 __attribute__((ext_vector_type(4)));
typedef short bf16x8 __attribute__((ext_vector_type(8)));
typedef GAS unsigned gu32;
typedef GAS unsigned long long gu64;
#define RLX_AGENT __ATOMIC_RELAXED, __HIP_MEMORY_SCOPE_AGENT
#define LDS_WAIT() asm volatile("s_waitcnt lgkmcnt(0)" ::: "memory")
#define VM_WAIT() asm volatile("s_waitcnt vmcnt(0)" ::: "memory")
__device__ __forceinline__ unsigned long long rt() { return __builtin_amdgcn_s_memrealtime(); }
__device__ __forceinline__ unsigned f2bf(float f) { unsigned u = __builtin_bit_cast(unsigned, f); return (u + 0x7fffu + ((u >> 16) & 1u)) >> 16; }
__device__ __forceinline__ unsigned pk2(float lo, float hi) { return f2bf(lo) | (f2bf(hi) << 16); }
#define XB_TMO      128
#define XB_XCNT(j)  (256  + 64 * (j))
#define XB_XSUB(j)  (1280 + 64 * (j))
#define XB_XGEN(j)  (2304 + 64 * (j))
#define XB_TOP      3328
#define XB_TOPGEN   3392
#define XCD_BAR_WORDS 3456
#define XB_SPIN_CAP (1u << 18)

__device__ __forceinline__ unsigned xb_ld(unsigned* p)              { return __hip_atomic_load(p, __ATOMIC_RELAXED, __HIP_MEMORY_SCOPE_AGENT); }
__device__ __forceinline__ unsigned xb_add(unsigned* p, unsigned v) { return __hip_atomic_fetch_add(p, v, __ATOMIC_RELAXED, __HIP_MEMORY_SCOPE_AGENT); }
__device__ __forceinline__ unsigned xb_xcc_id() { return (unsigned)__builtin_amdgcn_s_getreg((3 << 11) | 20) & 0xFu; }
#define XB_SPIN(cond, bar) do { unsigned _sp = 0; while (cond) { __builtin_amdgcn_s_sleep(1); \
    if ((++_sp & 255u) == 0u) { if (xb_ld(&(bar)[XB_TMO])) break; if (_sp > XB_SPIN_CAP) { atomicAdd(&(bar)[XB_TMO], 1u); break; } } } } while (0)

struct XcdBarrier {
    unsigned* bar; unsigned x;
    volatile LAS unsigned* st;
};

__device__ __forceinline__ XcdBarrier xcd_barrier_post(unsigned* bar, volatile LAS unsigned* st) {
    XcdBarrier b; b.bar = bar; b.x = xb_xcc_id(); b.st = st;
    if (threadIdx.x == 0) (void)xb_add(&bar[XB_XCNT(b.x)], 1u);
    return b;
}
__device__ __forceinline__ void xcd_barrier_complete(unsigned* bar, unsigned x, unsigned& nloc, unsigned& nx) {
    const unsigned G = gridDim.x * gridDim.y * gridDim.z;
    unsigned sum, cnt, mine, sp = 0u;
    for (;;) {
        sum = 0u; cnt = 0u; mine = 0u;
#pragma unroll
        for (unsigned j = 0; j < 16; ++j) { const unsigned c = xb_ld(&bar[XB_XCNT(j)]); sum += c; cnt += (c > 0u) ? 1u : 0u; mine = (j == x) ? c : mine; }
        if (sum == G) break;
        __builtin_amdgcn_s_sleep(1);
        if ((++sp & 255u) == 0u) { if (xb_ld(&bar[XB_TMO])) break; if (sp > XB_SPIN_CAP) { atomicAdd(&bar[XB_TMO], 1u); break; } }
    }
    nloc = mine > 0u ? mine : 1u; nx = cnt > 0u ? cnt : 1u;
}

__device__ __forceinline__ void xcd_barrier(const XcdBarrier& b) {
    asm volatile("s_waitcnt vmcnt(0)" ::: "memory");
    __syncthreads();
    if (threadIdx.x == 0) {
        unsigned* bar = b.bar;
        __builtin_amdgcn_s_waitcnt(0);
        unsigned nloc = b.st[0], nx = b.st[1];
        if (nloc == 0u) { xcd_barrier_complete(bar, b.x, nloc, nx); b.st[0] = nloc; b.st[1] = nx; }
        const unsigned old = xb_add(&bar[XB_XSUB(b.x)], 1u);
        const unsigned gen = old / nloc;
        if (old + 1u == (gen + 1u) * nloc) {
            __builtin_amdgcn_fence(__ATOMIC_RELEASE, "agent");
            asm volatile("s_waitcnt vmcnt(0)" ::: "memory");
            const unsigned og = xb_add(&bar[XB_TOP], 1u);
            const unsigned tg = og / nx;
            if (og + 1u == (tg + 1u) * nx) xb_add(&bar[XB_TOPGEN], 1u);
            else XB_SPIN(xb_ld(&bar[XB_TOPGEN]) == tg, bar);
            __builtin_amdgcn_fence(__ATOMIC_ACQUIRE, "agent");
            xb_add(&bar[XB_XGEN(b.x)], 1u);
            asm volatile("s_waitcnt vmcnt(0)" ::: "memory");
        } else {
            XB_SPIN(xb_ld(&bar[XB_XGEN(b.x)]) == gen, bar);
            __builtin_amdgcn_fence(__ATOMIC_ACQUIRE, "agent");
            asm volatile("s_waitcnt vmcnt(0)" ::: "memory");
        }
    }
    __syncthreads();
}
constexpr int NWAVES = 8;
constexpr int BATCH = 8, T = 2048, D = 1024, M = BATCH * T, NMEM = 256, MMEM = BATCH * NMEM, CHUNK = 64, NCH = T / CHUNK;
constexpr int NIN = 4696, NIN_PAD = 4864, PJ = 4704, DFF = 2816;
constexpr int C_GQ = 0, C_GK = 512, C_GV = 1024, C_GZ = 1536, C_DQ = 2048, C_DK = 2560, C_DV = 3072, C_IQ = 3584, C_IK = 4608, C_IW = 4672, C_GB = 4688, C_GA = 4692;
constexpr size_t MiB = 1u << 20;
constexpr size_t WS_CTL = 0, CTL_ZERO_BYTES = 1 * MiB;
constexpr size_t WS_SSQ1 = 256 * 1024, WS_SSQ2 = 320 * 1024;
constexpr size_t WS_SSQ0 = 1 * MiB, WS_SSQM = WS_SSQ0 + 65536, WS_GLAST = WS_SSQM + 8192;
constexpr size_t WS_WIN = 2 * MiB, WS_WOUT = 12 * MiB, WS_WXQ = 14 * MiB, WS_WXKV = 15 * MiB, WS_WXO = 17 * MiB, WS_WGU = 18 * MiB, WS_WDOWN = 29 * MiB;
constexpr size_t WS_MEMB = 35 * MiB, WS_KM = 39 * MiB, WS_VTM = 41 * MiB;
constexpr size_t WS_XB = 44 * MiB;
constexpr size_t WS_PROJ = 76 * MiB;
constexpr size_t WS_YMIX = 223 * MiB;
constexpr size_t WS_XQ = 76 * MiB, WS_XO = 92 * MiB, WS_ACT = 108 * MiB;
constexpr size_t WS_END = 256 * MiB;
constexpr int CW_TMO = 0, CW_CODE = 1, CW_BAR = 4096;
constexpr int RING_OFF = 0, RING_BYTES = 131072;
constexpr int LDS_BYTES = 155648;
constexpr int LDSCTL_OFF = LDS_BYTES - 512, MISC_OFF = LDSCTL_OFF + 320;
struct Frame {
    LAS unsigned char* lds;
    volatile LAS unsigned* MISC;
    gu32* ctl;
    int tid, lane, wave, vcu, G;
    const float* in[21]; float* out; unsigned char* ws;
};
enum { I_X = 0, I_MEM, I_GMIX, I_WIN, I_CONVW, I_ALOG, I_DTB, I_GGDN, I_GQD, I_GKD, I_WOUT, I_GXA, I_GMEM, I_WXQ, I_WXKV, I_GXQ, I_GXK, I_WXO, I_GFFN, I_WGU, I_WDOWN };
typedef float f32x2_t __attribute__((ext_vector_type(2))); typedef __bf16 bf16x2_t __attribute__((ext_vector_type(2)));
__device__ __forceinline__ unsigned cvtpk(float lo, float hi) { f32x2_t v = {lo, hi}; bf16x2_t b = __builtin_convertvector(v, bf16x2_t); return __builtin_bit_cast(unsigned, b); }
__device__ __forceinline__ float bf2f(unsigned short b) { return __builtin_bit_cast(float, (unsigned)b << 16); }
__device__ __forceinline__ float bflo(unsigned w) { return __builtin_bit_cast(float, w << 16); }
__device__ __forceinline__ float bfhi(unsigned w) { return __builtin_bit_cast(float, w & 0xffff0000u); }
__device__ __forceinline__ float wave_sum(float v) {
#pragma unroll
    for (int o = 1; o < 64; o <<= 1) v += __shfl_xor(v, o);
    return v;
}
__device__ __forceinline__ int srccol(int mode, int dr) {
    if (mode == 1) return dr < 2048 ? dr : (dr < 4688 ? dr + 8 : (dr < NIN ? dr - 4688 + 2048 : -1));
    if (mode == 2) { const int pn = dr >> 8, j = dr & 255; return j < 128 ? 128 * pn + j : DFF + 128 * pn + (j - 128); }
    return dr;
}
struct TrItem { const float* W; bf16* WT; const float* gain; int K, Nsrc, nblk, mode, idx; };
__device__ __forceinline__ void tr_load(const TrItem& t, int lane, f32x4 (&v)[16]) {
    const int kb = t.idx / t.nblk, nb = t.idx % t.nblk, k0 = 64 * kb, n0 = 64 * nb;
    const int c4 = (lane & 15) * 4, rr = lane >> 4;
    const int s0 = srccol(t.mode, n0 + c4);
    const bool vec = (s0 >= 0) && (srccol(t.mode, n0 + c4 + 3) == s0 + 3) && ((s0 & 3) == 0) && ((t.Nsrc & 3) == 0);
#pragma unroll
    for (int i = 0; i < 16; ++i) { const int kk = 4 * i + rr;
        if (vec) v[i] = *(const GAS f32x4*)(t.W + (size_t)(k0 + kk) * t.Nsrc + s0);
        else {
#pragma unroll
            for (int e = 0; e < 4; ++e) { const int sc = srccol(t.mode, n0 + c4 + e); v[i][e] = (sc >= 0) ? t.W[(size_t)(k0 + kk) * t.Nsrc + sc] : 0.f; } } }
}
__device__ __forceinline__ void tr_finish(const TrItem& t, int lane, f32x4 (&v)[16], LAS float* scr) {
    const int kb = t.idx / t.nblk, nb = t.idx % t.nblk, k0 = 64 * kb, n0 = 64 * nb;
    const int c4 = (lane & 15) * 4, rr = lane >> 4;
#pragma unroll
    for (int i = 0; i < 16; ++i) { const int kk = 4 * i + rr; f32x4 x = v[i]; if (t.gain) x = x * t.gain[k0 + kk];
        LAS float* d = scr + kk * 65 + c4; d[0] = x[0]; d[1] = x[1]; d[2] = x[2]; d[3] = x[3]; }
    LDS_WAIT(); asm volatile("" ::: "memory");
    const int kq = lane & 7;
#pragma unroll
    for (int j = 0; j < 8; ++j) { const int n = (lane >> 3) + 8 * j; const LAS float* s = scr + (8 * kq) * 65 + n;
        v4u o; o.x = cvtpk(s[0 * 65], s[1 * 65]); o.y = cvtpk(s[2 * 65], s[3 * 65]); o.z = cvtpk(s[4 * 65], s[5 * 65]); o.w = cvtpk(s[6 * 65], s[7 * 65]);
        *(GAS v4u*)(t.WT + (size_t)(n0 + n) * t.K + k0 + 8 * kq) = o; }
    LDS_WAIT(); asm volatile("" ::: "memory");
}
template <int NR> __device__ __forceinline__ void rows_to_bf16_ssq(Frame& F, const float* x, bf16* o, float* ssq, int m0, int stride, int mend) {
    f32x4 v[NR][4];
#pragma unroll
    for (int r = 0; r < NR; ++r) { const int m = (m0 + r * stride < mend) ? m0 + r * stride : m0; const GAS f32x4* xr = (const GAS f32x4*)(x + (size_t)m * D) + F.lane;
#pragma unroll
        for (int j = 0; j < 4; ++j) v[r][j] = xr[64 * j]; }
#pragma unroll
    for (int r = 0; r < NR; ++r) { const int m = m0 + r * stride; if (m < mend) { float s = 0.f;
#pragma unroll
        for (int j = 0; j < 4; ++j) s += (v[r][j].x * v[r][j].x + v[r][j].y * v[r][j].y) + (v[r][j].z * v[r][j].z + v[r][j].w * v[r][j].w);
        s = wave_sum(s);
        GAS unsigned long long* o8 = (GAS unsigned long long*)(o + (size_t)m * D) + F.lane;
#pragma unroll
        for (int j = 0; j < 4; ++j) o8[64 * j] = (unsigned long long)cvtpk(v[r][j].x, v[r][j].y) | ((unsigned long long)cvtpk(v[r][j].z, v[r][j].w) << 32);
        if (F.lane == 0) ssq[m] = s; } }
}
__device__ __forceinline__ void p0_transposes(Frame& F, int it_lo, int it_hi, int gw, int NGW) {
    LAS float* scr = (LAS float*)(F.lds + RING_OFF + F.wave * 17408);
    constexpr int I_0 = 16 * (NIN_PAD / 64), I_1 = 16 * 16, I_2 = 16 * 8, I_3 = 16 * 16, I_4 = 8 * 16, I_5 = 16 * (2 * DFF / 64), I_6 = (DFF / 64) * 16;
    constexpr int NITEMS = I_0 + I_1 + I_2 + I_3 + I_4 + I_5 + I_6;
    unsigned char* ws = F.ws;
    auto decode = [&](int it, TrItem& t) { int r = it;
        if (r < I_0) { t = TrItem{F.in[I_WIN], (bf16*)(ws + WS_WIN), F.in[I_GMIX], D, NIN, NIN_PAD / 64, 1, r}; return; } r -= I_0;
        if (r < I_1) { t = TrItem{F.in[I_WOUT], (bf16*)(ws + WS_WOUT), nullptr, D, D, 16, 0, r}; return; } r -= I_1;
        if (r < I_2) { t = TrItem{F.in[I_WXQ], (bf16*)(ws + WS_WXQ), F.in[I_GXA], D, 512, 8, 0, r}; return; } r -= I_2;
        if (r < I_3) { t = TrItem{F.in[I_WXKV], (bf16*)(ws + WS_WXKV), F.in[I_GMEM], D, 1024, 16, 0, r}; return; } r -= I_3;
        if (r < I_4) { t = TrItem{F.in[I_WXO], (bf16*)(ws + WS_WXO), nullptr, 512, D, 16, 0, r}; return; } r -= I_4;
        if (r < I_5) { t = TrItem{F.in[I_WGU], (bf16*)(ws + WS_WGU), F.in[I_GFFN], D, 2 * DFF, 2 * DFF / 64, 2, r}; return; } r -= I_5;
        t = TrItem{F.in[I_WDOWN], (bf16*)(ws + WS_WDOWN), nullptr, DFF, D, 16, 0, r}; };
    { int it = it_lo + gw; TrItem cur{}, nxt{}; f32x4 vc[16], vn[16];
      if (it < it_hi) { decode(it, cur); tr_load(cur, F.lane, vc); }
      while (it < it_hi) { const int itn = it + NGW; const bool more = itn < it_hi;
          if (more) { decode(itn, nxt); tr_load(nxt, F.lane, vn); }
          tr_finish(cur, F.lane, vc, scr);
          if (more) { cur = nxt;
#pragma unroll
              for (int i = 0; i < 16; ++i) vc[i] = vn[i]; }
          it = itn; } }
}
constexpr int TR_EARLY = 16 * (NIN_PAD / 64) + 16 * 16 + 16 * 8 + 16 * 16 + 8 * 16, TR_ALL = TR_EARLY + 16 * (2 * DFF / 64) + (DFF / 64) * 16;
__device__ __forceinline__ void p0_prologue(Frame& F) {
    const int gw = F.vcu * NWAVES + F.wave, NGW = F.G * NWAVES; unsigned char* ws = F.ws;
    p0_transposes(F, 0, TR_EARLY, gw, NGW);
    for (int m = gw; m < M; m += 4 * NGW) rows_to_bf16_ssq<4>(F, F.in[I_X], (bf16*)(ws + WS_XB), (float*)(ws + WS_SSQ0), m, NGW, M);
    for (int m = gw; m < MMEM; m += NGW) rows_to_bf16_ssq<1>(F, F.in[I_MEM], (bf16*)(ws + WS_MEMB), (float*)(ws + WS_SSQM), m, NGW, MMEM);
}
typedef float f32x16 __attribute__((ext_vector_type(16)));
typedef float f32x4v __attribute__((ext_vector_type(4)));
constexpr int GD_ITEM = 40960, GD_U = 0, GD_W = 16384, GD_QK = 32768, GX_ITEM = 32768, GX_QD = 0, GX_KT = 16384;
__device__ __forceinline__ int crow(int r, int hi) { return (r & 3) + 8 * (r >> 2) + 4 * hi; }
__device__ __forceinline__ float fast_exp(float x) { return __builtin_amdgcn_exp2f(x * 1.4426950408889634f); }
__device__ __forceinline__ float silu_f(float g) { return g * __builtin_amdgcn_rcpf(1.0f + __builtin_amdgcn_exp2f(g * -1.4426950408889634f)); }
constexpr int PL_KN = 0, PL_QN = 16384, PL_KT1 = 32768, PL_KT2 = 49152, PL_VT = 65536, PL_AM = 81920, PL_TF = 98304, PL_SC = 106496, PL_CW = 107520;
__device__ __forceinline__ void gdn_prep_item(Frame& F, int it) {
    int tid_ = F.tid; asm volatile("" : "+v"(tid_));
    const int tid = tid_, lane = tid & 63, wv = F.wave;
    const int bh = it >> 5, n = it & 31, b = bh >> 2, h = bh & 3;
    const bf16* PROJ = (const bf16*)(F.ws + WS_PROJ);
    unsigned char* gd = (unsigned char*)F.out + (size_t)it * GD_ITEM;
    unsigned char* gx = F.ws + WS_XB + (size_t)it * GX_ITEM;
    LAS unsigned char* L = F.lds;
    LAS float* gs = (LAS float*)(L + PL_SC); LAS float* dcy = gs + 64; LAS float* bet = gs + 128;
    const int p = tid >> 3, sg = tid & 7, t = n * 64 + p; const size_t row = (size_t)b * T + t;
    const float bl = bf2f(PROJ[row * PJ + C_GB + h]), al = bf2f(PROJ[row * PJ + C_GA + h]) + F.in[I_DTB][h];
    if (tid < 384) { const int j = tid / 96, rem = tid % 96, X = rem >> 5, c4 = (rem & 31) * 4;
        *(LAS f32x4v*)(L + PL_CW + (j * 384 + X * 128 + c4) * 4) = *(const GAS f32x4v*)(F.in[I_CONVW] + j * 1536 + X * 512 + h * 128 + c4); }
    float qv[16], kv[16], vv[16];
#pragma unroll
    for (int c = 0; c < 16; ++c) { qv[c] = 0.f; kv[c] = 0.f; vv[c] = 0.f; }
    __syncthreads();
#pragma unroll 1
    for (int jp = 0; jp < 2; ++jp) {
        v4u raw[2][3][2]; float tapw[2];
#pragma unroll
        for (int j2 = 0; j2 < 2; ++j2) { const int j = 2 * jp + j2; const bool ok = (t - 3 + j) >= 0; tapw[j2] = ok ? 1.0f : 0.0f; const bf16* rp = PROJ + (ok ? row - 3 + j : row) * PJ + h * 128 + sg * 16;
#pragma unroll
            for (int X = 0; X < 3; ++X) { raw[j2][X][0] = *(const GAS v4u*)(rp + X * 512); raw[j2][X][1] = *(const GAS v4u*)(rp + X * 512 + 8); } }
#pragma unroll
        for (int j2 = 0; j2 < 2; ++j2)
#pragma unroll
            for (int X = 0; X < 3; ++X) { const LAS f32x4v* wp = (const LAS f32x4v*)(L + PL_CW + ((2 * jp + j2) * 384 + X * 128 + sg * 16) * 4); float w[16];
#pragma unroll
                for (int q4 = 0; q4 < 4; ++q4) { const f32x4v w4 = wp[q4]; w[4 * q4] = w4[0] * tapw[j2]; w[4 * q4 + 1] = w4[1] * tapw[j2]; w[4 * q4 + 2] = w4[2] * tapw[j2]; w[4 * q4 + 3] = w4[3] * tapw[j2]; }
                const unsigned rw[8] = {raw[j2][X][0].x, raw[j2][X][0].y, raw[j2][X][0].z, raw[j2][X][0].w, raw[j2][X][1].x, raw[j2][X][1].y, raw[j2][X][1].z, raw[j2][X][1].w};
#pragma unroll
                for (int c2 = 0; c2 < 8; ++c2) { const float x0 = bflo(rw[c2]), x1 = bfhi(rw[c2]);
                    if (X == 0) { qv[2 * c2] += w[2 * c2] * x0; qv[2 * c2 + 1] += w[2 * c2 + 1] * x1; } else if (X == 1) { kv[2 * c2] += w[2 * c2] * x0; kv[2 * c2 + 1] += w[2 * c2 + 1] * x1; } else { vv[2 * c2] += w[2 * c2] * x0; vv[2 * c2 + 1] += w[2 * c2 + 1] * x1; } } }
    }
    float sq = 0.f, sk = 0.f;
#pragma unroll
    for (int c = 0; c < 16; ++c) { qv[c] = silu_f(qv[c]); kv[c] = silu_f(kv[c]); vv[c] = silu_f(vv[c]); sq += qv[c] * qv[c]; sk += kv[c] * kv[c]; }
    sq += __shfl_xor(sq, 1); sq += __shfl_xor(sq, 2); sq += __shfl_xor(sq, 4); sk += __shfl_xor(sk, 1); sk += __shfl_xor(sk, 2); sk += __shfl_xor(sk, 4);
    const float rq = __builtin_amdgcn_rsqf(sq + 1e-6f) * 0.08838834764831845f, rk = __builtin_amdgcn_rsqf(sk + 1e-6f);
    const float beta = __builtin_amdgcn_rcpf(1.0f + fast_exp(-bl));
    const float sp = (al > 20.f) ? al : __logf(1.0f + fast_exp(al));
    const float g = -__expf(F.in[I_ALOG][h]) * sp;
    if (sg == 0) { gs[p] = g; bet[p] = beta; }
    __syncthreads();
    if (wv == 0) {
        float v = gs[lane];
#pragma unroll
        for (int o = 1; o < 64; o <<= 1) { const float u = __shfl_up(v, o); if (lane >= o) v += u; }
        dcy[lane] = v;
    }
    __syncthreads();
    const float dp = dcy[p], dl = dcy[63];
    const float e_p = __expf(dp), el_p = __expf(dl - dp);
    if (tid == 0) ((float*)(F.ws + WS_GLAST))[it] = __expf(dl);
    {
        const int Fq = (p >> 5) * 8 + sg; const int l0 = (p & 31);
        unsigned kn[8], qn[8], qd[8];
#pragma unroll
        for (int c2 = 0; c2 < 8; ++c2) { kn[c2] = cvtpk(kv[2 * c2] * rk, kv[2 * c2 + 1] * rk); qn[c2] = cvtpk(qv[2 * c2] * rq, qv[2 * c2 + 1] * rq); qd[c2] = cvtpk(qv[2 * c2] * rq * e_p, qv[2 * c2 + 1] * rq * e_p); }
#pragma unroll
        for (int hf = 0; hf < 2; ++hf) { const int off = Fq * 1024 + (l0 + 32 * hf) * 16;
            *(LAS v4u*)(L + PL_KN + off) = (v4u){kn[4 * hf], kn[4 * hf + 1], kn[4 * hf + 2], kn[4 * hf + 3]};
            *(LAS v4u*)(L + PL_QN + off) = (v4u){qn[4 * hf], qn[4 * hf + 1], qn[4 * hf + 2], qn[4 * hf + 3]};
            *(GAS v4u*)(gx + GX_QD + off) = (v4u){qd[4 * hf], qd[4 * hf + 1], qd[4 * hf + 2], qd[4 * hf + 3]}; }
        const float s1 = rk * el_p, s2 = rk * beta * e_p;
#pragma unroll
        for (int c = 0; c < 16; ++c) { const int ch = sg * 16 + c;
            *(LAS unsigned short*)(L + PL_KT1 + ch * 128 + p * 2) = (unsigned short)(cvtpk(kv[c] * s1, 0.f) & 0xffffu);
            *(LAS unsigned short*)(L + PL_KT2 + ch * 128 + p * 2) = (unsigned short)(cvtpk(kv[c] * s2, 0.f) & 0xffffu);
            *(LAS unsigned short*)(L + PL_VT + ch * 128 + p * 2) = (unsigned short)(cvtpk(vv[c] * beta, 0.f) & 0xffffu); }
    }
    __syncthreads();
    {
        const int w4 = wv & 3, ta = w4 >> 1, tb = w4 & 1; const bool isqk = wv >= 4;
        f32x16 acc = {};
#pragma unroll
        for (int ks = 0; ks < 8; ++ks) { const bf16x8 a = *(const LAS bf16x8*)(L + PL_KN + (ta * 8 + ks) * 1024 + lane * 16);
            const bf16x8 bb = *(const LAS bf16x8*)(L + (isqk ? PL_QN : PL_KN) + (tb * 8 + ks) * 1024 + lane * 16);
            acc = __builtin_amdgcn_mfma_f32_32x32x16_bf16(a, bb, acc, 0, 0, 0); }
        const int hi = lane >> 5, cn = 32 * tb + (lane & 31);
        const float dn = dcy[cn];
        f32x4 dr[4], br[4];
#pragma unroll
        for (int g4 = 0; g4 < 4; ++g4) { dr[g4] = *(const LAS f32x4*)(dcy + 32 * ta + 4 * hi + 8 * g4); br[g4] = *(const LAS f32x4*)(bet + 32 * ta + 4 * hi + 8 * g4); }
        const int rbase = 32 * ta + 4 * hi;
        if (!isqk) {
#pragma unroll
            for (int r = 0; r < 16; ++r) { const int i = rbase + (r & 3) + 8 * (r >> 2); const float ex = __expf(fminf(dr[r >> 2][r & 3] - dn, 0.f));
                const float v = (i > cn) ? br[r >> 2][r & 3] * acc[r] * ex : 0.f;
                ((LAS float*)(L + PL_AM))[i * 64 + (cn & 7) * 8 + (cn >> 3)] = v; }
        } else {
#pragma unroll
            for (int gq = 0; gq < 4; ++gq) { float v[4];
#pragma unroll
                for (int e = 0; e < 4; ++e) { const int j = rbase + e + 8 * gq; const float ex = __expf(fminf(dn - dr[gq][e], 0.f)); v[e] = (cn >= j) ? acc[4 * gq + e] * ex : 0.f; }
                const int Fk = tb * 4 + 2 * ta + (gq >> 1);
                *(GAS unsigned long long*)(gd + GD_QK + Fk * 1024 + ((lane & 31) + 32 * (gq & 1)) * 16 + 8 * hi) = (unsigned long long)cvtpk(v[0], v[1]) | ((unsigned long long)cvtpk(v[2], v[3]) << 32); }
        }
    }
    __syncthreads();
    {
        const int cw = lane >> 3, r = lane & 7, c = 8 * wv + cw; float tt[8];
#pragma unroll
        for (int k = 0; k < 8; ++k) tt[k] = 0.f;
        const LAS float* AM = (const LAS float*)(L + PL_AM) + r * 8;
#pragma unroll
        for (int i = 0; i < 64; ++i) {
            float s0 = 0.f, s1 = 0.f;
            if (i > 0) { const f32x4v a0 = *(const LAS f32x4v*)(AM + i * 64); s0 = a0[0] * tt[0]; if (i > 8) s1 = a0[1] * tt[1]; if (i > 16) s0 += a0[2] * tt[2]; if (i > 24) s1 += a0[3] * tt[3]; }
            if (i > 32) { const f32x4v a1 = *(const LAS f32x4v*)(AM + i * 64 + 4); s0 += a1[0] * tt[4]; if (i > 40) s1 += a1[1] * tt[5]; if (i > 48) s0 += a1[2] * tt[6]; if (i > 56) s1 += a1[3] * tt[7]; }
            float s = s0 + s1;
            s += __builtin_bit_cast(float, __builtin_amdgcn_update_dpp(0, __builtin_bit_cast(int, s), 0xB1, 0xf, 0xf, false));
            s += __builtin_bit_cast(float, __builtin_amdgcn_update_dpp(0, __builtin_bit_cast(int, s), 0x4E, 0xf, 0xf, false));
            s += __builtin_bit_cast(float, __builtin_amdgcn_update_dpp(0, __builtin_bit_cast(int, s), 0x141, 0xf, 0xf, false));
            const float val = ((i == c) ? 1.0f : 0.0f) - s;
            tt[i >> 3] = (r == (i & 7)) ? val : tt[i >> 3];
            if ((i & 3) == 3) asm volatile("" ::: "memory");
        }
#pragma unroll
        for (int k = 0; k < 8; ++k) { const int i = 8 * k + r;
            *(LAS unsigned short*)(L + PL_TF + ((i >> 5) * 4 + (c >> 4)) * 1024 + ((i & 31) + 32 * ((c >> 3) & 1)) * 16 + (c & 7) * 2) = (unsigned short)(cvtpk(tt[k], 0.f) & 0xffffu); }
    }
    __syncthreads();
    {
        const int hi = lane >> 5;
        { const int ib = wv >> 2, e = wv & 3; f32x16 acc = {};
#pragma unroll
          for (int ks = 0; ks < 4; ++ks) { const bf16x8 a = *(const LAS bf16x8*)(L + PL_TF + (ib * 4 + ks) * 1024 + lane * 16);
              const bf16x8 bb = *(const LAS bf16x8*)(L + PL_VT + (32 * e + (lane & 31)) * 128 + (16 * ks + 8 * hi) * 2);
              acc = __builtin_amdgcn_mfma_f32_32x32x16_bf16(a, bb, acc, 0, 0, 0); }
          unsigned w[8];
#pragma unroll
          for (int r2 = 0; r2 < 8; ++r2) w[r2] = cvtpk(acc[2 * r2], acc[2 * r2 + 1]);
          GAS v4u* dst = (GAS v4u*)(gd + GD_U + (ib * 4 + e) * 2048 + lane * 32);
          dst[0] = (v4u){w[0], w[1], w[2], w[3]}; dst[1] = (v4u){w[4], w[5], w[6], w[7]}; }
        { const int a4 = wv >> 1, ib = wv & 1; f32x16 acc = {};
#pragma unroll
          for (int ks = 0; ks < 4; ++ks) { const bf16x8 a = *(const LAS bf16x8*)(L + PL_KT2 + (32 * a4 + (lane & 31)) * 128 + (16 * ks + 8 * hi) * 2);
              const bf16x8 bb = *(const LAS bf16x8*)(L + PL_TF + (ib * 4 + ks) * 1024 + lane * 16);
              acc = __builtin_amdgcn_mfma_f32_32x32x16_bf16(a, bb, acc, 0, 0, 0); }
#pragma unroll
          for (int gq = 0; gq < 4; ++gq) { const unsigned w0 = cvtpk(acc[4 * gq], acc[4 * gq + 1]), w1 = cvtpk(acc[4 * gq + 2], acc[4 * gq + 3]);
              const int Fw = ib * 8 + 2 * a4 + (gq >> 1);
              *(GAS unsigned long long*)(gd + GD_W + Fw * 1024 + ((lane & 31) + 32 * (gq & 1)) * 16 + 8 * hi) = (unsigned long long)w0 | ((unsigned long long)w1 << 32); } }
#pragma unroll
        for (int q2 = 0; q2 < 2; ++q2) { const int piece = tid + 512 * q2, Fk = piece >> 6, l2 = piece & 63; const int dk = 32 * (Fk >> 2) + (l2 & 31), pos0 = 16 * (Fk & 3) + 8 * (l2 >> 5);
            *(GAS v4u*)(gx + GX_KT + piece * 16) = *(const LAS v4u*)(L + PL_KT1 + dk * 128 + pos0 * 2); }
    }
    __syncthreads();
}
constexpr int SL_S = 0, SL_V = 32768, SL_W = 49152, SL_Q = 65536, SL_K = 81920, SL_QK = 98304, SL_O = 106496, SL_OPITCH = 528;
__device__ __forceinline__ void glds_piece(const unsigned char* gsrc_lane, LAS unsigned char* ldst_uniform) {
    __builtin_amdgcn_global_load_lds((const GAS unsigned*)gsrc_lane, (LAS unsigned*)ldst_uniform, 16, 0, 0);
}
__device__ __forceinline__ void gdn_scan_bh(Frame& F, int bh) {
    const int tid = F.tid, lane = F.lane, wv = F.wave, hi = lane >> 5, l31 = lane & 31;
    const int ib = wv & 1, e = wv >> 1, b = bh >> 2, h = bh & 3;
    LAS unsigned char* L = F.lds;
    const unsigned char* gd0 = (const unsigned char*)F.out + (size_t)(bh * 32) * GD_ITEM;
    const unsigned char* gx0 = F.ws + WS_XB + (size_t)(bh * 32) * GX_ITEM;
    const float* glast = (const float*)(F.ws + WS_GLAST) + bh * 32;
    const bf16* PROJ = (const bf16*)(F.ws + WS_PROJ); bf16* YMIX = (bf16*)(F.ws + WS_YMIX);
    for (int i = tid; i < 32768 / 16; i += 512) *(LAS v4u*)(L + SL_S + i * 16) = (v4u){0u, 0u, 0u, 0u};
    f32x16 S0 = {}, S1 = {};
    const int np = tid >> 3, dv0 = (tid & 7) * 16;
    float gout[16];
#pragma unroll
    for (int c = 0; c < 16; ++c) gout[c] = F.in[I_GGDN][dv0 + c];
#pragma unroll
    for (int q = 0; q < 2; ++q) { const int pc = wv * 2 + q; glds_piece(gd0 + GD_W + pc * 1024 + lane * 16, L + SL_W + pc * 1024); glds_piece(gx0 + GX_QD + pc * 1024 + lane * 16, L + SL_Q + pc * 1024); }
    v4u u0 = *(const GAS v4u*)(gd0 + GD_U + (ib * 4 + e) * 2048 + lane * 32), u1 = *(const GAS v4u*)(gd0 + GD_U + (ib * 4 + e) * 2048 + lane * 32 + 16);
    v4u z0 = {}, z1 = {};
    for (int n = 0; n < 32; ++n) {
        const unsigned char* gd = gd0 + (size_t)n * GD_ITEM; const unsigned char* gx = gx0 + (size_t)n * GX_ITEM;
        asm volatile("s_waitcnt vmcnt(0) lgkmcnt(0)" ::: "memory"); __builtin_amdgcn_s_barrier(); asm volatile("" ::: "memory");
#pragma unroll
        for (int q = 0; q < 2; ++q) { const int pc = wv * 2 + q; glds_piece(gx + GX_KT + pc * 1024 + lane * 16, L + SL_K + pc * 1024); }
        glds_piece(gd + GD_QK + wv * 1024 + lane * 16, L + SL_QK + wv * 1024);
        f32x16 P1 = {}, O = {};
#pragma unroll
        for (int ks = 0; ks < 8; ++ks) { const bf16x8 sb = *(const LAS bf16x8*)(L + SL_S + (e * 8 + ks) * 1024 + lane * 16);
            const bf16x8 wa = *(const LAS bf16x8*)(L + SL_W + (ib * 8 + ks) * 1024 + lane * 16), qa = *(const LAS bf16x8*)(L + SL_Q + (ib * 8 + ks) * 1024 + lane * 16);
            P1 = __builtin_amdgcn_mfma_f32_32x32x16_bf16(wa, sb, P1, 0, 0, 0); O = __builtin_amdgcn_mfma_f32_32x32x16_bf16(qa, sb, O, 0, 0, 0); }
        { const unsigned uw[8] = {u0.x, u0.y, u0.z, u0.w, u1.x, u1.y, u1.z, u1.w};
#pragma unroll
          for (int g = 0; g < 4; ++g) { const float v0 = bflo(uw[2 * g]) - P1[4 * g], v1 = bfhi(uw[2 * g]) - P1[4 * g + 1], v2 = bflo(uw[2 * g + 1]) - P1[4 * g + 2], v3 = bfhi(uw[2 * g + 1]) - P1[4 * g + 3];
              *(LAS unsigned long long*)(L + SL_V + (e * 4 + 2 * ib + (g >> 1)) * 1024 + (l31 + 32 * (g & 1)) * 16 + 8 * hi) = (unsigned long long)cvtpk(v0, v1) | ((unsigned long long)cvtpk(v2, v3) << 32); } }
        if (n > 0) { const size_t row = (size_t)b * T + (n - 1) * 64 + np; float ov[16]; float ss = 0.f;
#pragma unroll
            for (int k = 0; k < 4; ++k) { const f32x4 t4 = *(const LAS f32x4*)(L + SL_O + np * SL_OPITCH + (dv0 + 4 * k) * 4); ov[4 * k] = t4[0]; ov[4 * k + 1] = t4[1]; ov[4 * k + 2] = t4[2]; ov[4 * k + 3] = t4[3]; }
#pragma unroll
            for (int c = 0; c < 16; ++c) ss += ov[c] * ov[c];
            ss += __builtin_bit_cast(float, __builtin_amdgcn_update_dpp(0, __builtin_bit_cast(int, ss), 0xB1, 0xf, 0xf, false)); ss += __builtin_bit_cast(float, __builtin_amdgcn_update_dpp(0, __builtin_bit_cast(int, ss), 0x4E, 0xf, 0xf, false)); ss += __builtin_bit_cast(float, __builtin_amdgcn_update_dpp(0, __builtin_bit_cast(int, ss), 0x141, 0xf, 0xf, false));
            const float rs = __builtin_amdgcn_rsqf(ss * (1.0f / 128.0f) + 1e-6f);
            const unsigned zw[8] = {z0.x, z0.y, z0.z, z0.w, z1.x, z1.y, z1.z, z1.w}; unsigned ow[8];
#pragma unroll
            for (int c2 = 0; c2 < 8; ++c2) ow[c2] = cvtpk(ov[2 * c2] * rs * gout[2 * c2] * silu_f(bflo(zw[c2])), ov[2 * c2 + 1] * rs * gout[2 * c2 + 1] * silu_f(bfhi(zw[c2])));
            GAS v4u* dst = (GAS v4u*)(YMIX + row * D + h * 128 + dv0); dst[0] = (v4u){ow[0], ow[1], ow[2], ow[3]}; dst[1] = (v4u){ow[4], ow[5], ow[6], ow[7]}; }
        asm volatile("s_waitcnt vmcnt(0) lgkmcnt(0)" ::: "memory"); __builtin_amdgcn_s_barrier(); asm volatile("" ::: "memory");
        if (n < 31) {
#pragma unroll
            for (int q = 0; q < 2; ++q) { const int pc = wv * 2 + q; glds_piece(gd + GD_ITEM + GD_W + pc * 1024 + lane * 16, L + SL_W + pc * 1024); glds_piece(gx + GX_ITEM + GX_QD + pc * 1024 + lane * 16, L + SL_Q + pc * 1024); }
            u0 = *(const GAS v4u*)(gd + GD_ITEM + GD_U + (ib * 4 + e) * 2048 + lane * 32); u1 = *(const GAS v4u*)(gd + GD_ITEM + GD_U + (ib * 4 + e) * 2048 + lane * 32 + 16);
        }
        { const bf16* zp = PROJ + ((size_t)b * T + n * 64 + np) * PJ + C_GZ + h * 128 + dv0; z0 = *(const GAS v4u*)zp; z1 = *(const GAS v4u*)(zp + 8); }
        const float last = glast[n];
        bf16x8 vb[4];
#pragma unroll
        for (int ks = 0; ks < 4; ++ks) vb[ks] = *(const LAS bf16x8*)(L + SL_V + (e * 4 + ks) * 1024 + lane * 16);
#pragma unroll
        for (int ks = 0; ks < 4; ++ks) { const bf16x8 qa = *(const LAS bf16x8*)(L + SL_QK + (ib * 4 + ks) * 1024 + lane * 16); O = __builtin_amdgcn_mfma_f32_32x32x16_bf16(qa, vb[ks], O, 0, 0, 0); }
#pragma unroll
        for (int r = 0; r < 16; ++r) { S0[r] *= last; S1[r] *= last; }
#pragma unroll
        for (int ks = 0; ks < 4; ++ks) { const bf16x8 k0 = *(const LAS bf16x8*)(L + SL_K + ((2 * ib) * 4 + ks) * 1024 + lane * 16), k1 = *(const LAS bf16x8*)(L + SL_K + ((2 * ib + 1) * 4 + ks) * 1024 + lane * 16);
            S0 = __builtin_amdgcn_mfma_f32_32x32x16_bf16(k0, vb[ks], S0, 0, 0, 0); S1 = __builtin_amdgcn_mfma_f32_32x32x16_bf16(k1, vb[ks], S1, 0, 0, 0); }
#pragma unroll
        for (int r = 0; r < 16; ++r) *(LAS float*)(L + SL_O + (32 * ib + crow(r, hi)) * SL_OPITCH + (32 * e + l31) * 4) = O[r];
#pragma unroll
        for (int g = 0; g < 4; ++g) {
            *(LAS unsigned long long*)(L + SL_S + (e * 8 + 2 * (2 * ib) + (g >> 1)) * 1024 + (l31 + 32 * (g & 1)) * 16 + 8 * hi) = (unsigned long long)cvtpk(S0[4 * g], S0[4 * g + 1]) | ((unsigned long long)cvtpk(S0[4 * g + 2], S0[4 * g + 3]) << 32);
            *(LAS unsigned long long*)(L + SL_S + (e * 8 + 2 * (2 * ib + 1) + (g >> 1)) * 1024 + (l31 + 32 * (g & 1)) * 16 + 8 * hi) = (unsigned long long)cvtpk(S1[4 * g], S1[4 * g + 1]) | ((unsigned long long)cvtpk(S1[4 * g + 2], S1[4 * g + 3]) << 32); }
    }
    asm volatile("s_waitcnt vmcnt(0) lgkmcnt(0)" ::: "memory"); __builtin_amdgcn_s_barrier(); asm volatile("" ::: "memory");
    { const size_t row = (size_t)b * T + 31 * 64 + np; float ov[16]; float ss = 0.f;
#pragma unroll
      for (int k = 0; k < 4; ++k) { const f32x4 t4 = *(const LAS f32x4*)(L + SL_O + np * SL_OPITCH + (dv0 + 4 * k) * 4); ov[4 * k] = t4[0]; ov[4 * k + 1] = t4[1]; ov[4 * k + 2] = t4[2]; ov[4 * k + 3] = t4[3]; }
#pragma unroll
      for (int c = 0; c < 16; ++c) ss += ov[c] * ov[c];
      ss += __builtin_bit_cast(float, __builtin_amdgcn_update_dpp(0, __builtin_bit_cast(int, ss), 0xB1, 0xf, 0xf, false)); ss += __builtin_bit_cast(float, __builtin_amdgcn_update_dpp(0, __builtin_bit_cast(int, ss), 0x4E, 0xf, 0xf, false)); ss += __builtin_bit_cast(float, __builtin_amdgcn_update_dpp(0, __builtin_bit_cast(int, ss), 0x141, 0xf, 0xf, false));
      const float rs = __builtin_amdgcn_rsqf(ss * (1.0f / 128.0f) + 1e-6f);
      const unsigned zw[8] = {z0.x, z0.y, z0.z, z0.w, z1.x, z1.y, z1.z, z1.w}; unsigned ow[8];
#pragma unroll
      for (int c2 = 0; c2 < 8; ++c2) ow[c2] = cvtpk(ov[2 * c2] * rs * gout[2 * c2] * silu_f(bflo(zw[c2])), ov[2 * c2 + 1] * rs * gout[2 * c2 + 1] * silu_f(bfhi(zw[c2])));
      GAS v4u* dst = (GAS v4u*)(YMIX + row * D + h * 128 + dv0); dst[0] = (v4u){ow[0], ow[1], ow[2], ow[3]}; dst[1] = (v4u){ow[4], ow[5], ow[6], ow[7]}; }
    __syncthreads();
}
constexpr size_t DO_MASK = 40 * MiB, DO_VT = 44 * MiB;
constexpr float DSA_QSCALE = 0.125f * 1.4426950408889634f;
constexpr int VL_PITCH = 1040;
__device__ __forceinline__ void dsa_norm_unit(Frame& F, int u) {
    const int tid = F.tid, b = u >> 5, c = u & 31; const size_t row0 = (size_t)b * T + 64 * c;
    bf16* PROJ = (bf16*)(F.ws + WS_PROJ); LAS unsigned char* L = F.lds;
#pragma unroll 2
    for (int it = 0; it < 16; ++it) { const int idx = it * 512 + tid, vec = idx >> 3, part = idx & 7, tok = vec >> 4, hs = vec & 15;
        bf16* p = PROJ + (row0 + tok) * PJ + (hs < 8 ? C_DQ + hs * 64 : C_DK + (hs - 8) * 64) + part * 8;
        const v4u raw = *(const GAS v4u*)p; const unsigned rw[4] = {raw.x, raw.y, raw.z, raw.w}; float x[8]; float ss = 0.f;
#pragma unroll
        for (int j = 0; j < 4; ++j) { x[2 * j] = bflo(rw[j]); x[2 * j + 1] = bfhi(rw[j]); ss += x[2 * j] * x[2 * j] + x[2 * j + 1] * x[2 * j + 1]; }
        ss += __shfl_xor(ss, 1); ss += __shfl_xor(ss, 2); ss += __shfl_xor(ss, 4);
        const float rs = __builtin_amdgcn_rsqf(ss * (1.0f / 64.0f) + 1e-6f) * (hs < 8 ? DSA_QSCALE : 1.0f);
        const float* g = (hs < 8 ? F.in[I_GQD] : F.in[I_GKD]) + part * 8; unsigned o[4];
#pragma unroll
        for (int j = 0; j < 4; ++j) o[j] = cvtpk(x[2 * j] * rs * g[2 * j], x[2 * j + 1] * rs * g[2 * j + 1]);
        if (hs < 8) *(GAS v4u*)p = (v4u){o[0], o[1], o[2], o[3]};
        else { const int hk = hs - 8, tb = 64 * c + tok, kt = tb >> 5;
            *(GAS v4u*)(PROJ + ((size_t)b * T + (hk * 64 + kt) * 4 + (part >> 1)) * PJ + C_GQ + ((tb & 31) + 32 * (part & 1)) * 8) = (v4u){o[0], o[1], o[2], o[3]}; } }
#pragma unroll 2
    for (int it = 0; it < 8; ++it) { const int idx = it * 512 + tid, tok = idx >> 6, ch = idx & 63;
        *(LAS v4u*)(L + tok * VL_PITCH + ch * 16) = *(const GAS v4u*)(PROJ + (row0 + tok) * PJ + C_DV + ch * 8); }
    __syncthreads();
    { const int col = tid, h = col >> 6, d = col & 63; unsigned char* vt = (unsigned char*)F.out + DO_VT + ((size_t)(b * 8 + h) * 64 + 2 * c) * 4096 + (d >> 5) * 2048 + (d & 31) * 16;
#pragma unroll
      for (int g16 = 0; g16 < 4; ++g16) { unsigned short e[16];
#pragma unroll
          for (int k = 0; k < 16; ++k) e[k] = *(const LAS unsigned short*)(L + (16 * g16 + k) * VL_PITCH + col * 2);
          const v4u lo = {(unsigned)e[0] | ((unsigned)e[1] << 16), (unsigned)e[2] | ((unsigned)e[3] << 16), (unsigned)e[8] | ((unsigned)e[9] << 16), (unsigned)e[10] | ((unsigned)e[11] << 16)};
          const v4u hi4 = {(unsigned)e[4] | ((unsigned)e[5] << 16), (unsigned)e[6] | ((unsigned)e[7] << 16), (unsigned)e[12] | ((unsigned)e[13] << 16), (unsigned)e[14] | ((unsigned)e[15] << 16)};
          unsigned char* bp = vt + (g16 >> 1) * 4096 + (g16 & 1) * 1024; *(GAS v4u*)bp = lo; *(GAS v4u*)(bp + 512) = hi4; } }
    __syncthreads();
}
constexpr int SC_PITCH = 2052;
__device__ __forceinline__ unsigned ordkey(float f) { const unsigned uu = __float_as_uint(f); return (uu & 0x80000000u) ? ~uu : (uu | 0x80000000u); }
constexpr int SC_HIST = 16 * SC_PITCH * 4;
__device__ __forceinline__ int wave_sum_i32(int x) {
    x += __builtin_amdgcn_update_dpp(0, x, 0x111, 0xf, 0xf, true); x += __builtin_amdgcn_update_dpp(0, x, 0x112, 0xf, 0xf, true);
    x += __builtin_amdgcn_update_dpp(0, x, 0x114, 0xf, 0xf, true); x += __builtin_amdgcn_update_dpp(0, x, 0x118, 0xf, 0xf, true);
    return __builtin_amdgcn_readlane(x, 15) + __builtin_amdgcn_readlane(x, 31) + __builtin_amdgcn_readlane(x, 47) + __builtin_amdgcn_readlane(x, 63);
}
__device__ __forceinline__ int count_ge(const unsigned (&v)[32], unsigned cand) {
    int c = 0;
#pragma unroll
    for (int i = 0; i < 32; ++i) c += (v[i] >= cand) ? 1 : 0;
    return wave_sum_i32(c);
}
__device__ __forceinline__ void dsa_index_unit(Frame& F, int b, int c, int qg) {
    const int tid = F.tid, lane = F.lane, wv = F.wave, q16 = lane & 15, kg = lane >> 4;
    const size_t row0 = (size_t)b * T; const int tq0 = 64 * c + 16 * qg;
    const bf16* PROJ = (const bf16*)(F.ws + WS_PROJ); LAS unsigned char* L = F.lds;
    const bf16* qrow = PROJ + (row0 + tq0 + q16) * PJ;
    for (int i = tid; i < 1024; i += 512) *(LAS v4u*)(L + SC_HIST + i * 16) = (v4u){0u, 0u, 0u, 0u};
    const int ntile = 4 * (c + 1);
    const bf16* kbase = PROJ + (row0 + q16) * PJ + C_IK + 8 * kg;
    __syncthreads();
    LAS unsigned* hq = (LAS unsigned*)(L + SC_HIST) + q16 * 256;
    const float finf = __builtin_inff();
#pragma unroll 1
    for (int ps = 0; ps < 2; ++ps) {
        bf16x8 qf[8][2]; float wq[8];
#pragma unroll
        for (int h = 0; h < 8; ++h) { qf[h][0] = *(const GAS bf16x8*)(qrow + C_IQ + (8 * ps + h) * 64 + 8 * kg); qf[h][1] = *(const GAS bf16x8*)(qrow + C_IQ + (8 * ps + h) * 64 + 32 + 8 * kg); wq[h] = bf2f(qrow[C_IW + 8 * ps + h]) * 0.03125f; }
        bf16x8 a0 = *(const GAS bf16x8*)(kbase + (size_t)(16 * wv) * PJ), a1 = *(const GAS bf16x8*)(kbase + (size_t)(16 * wv) * PJ + 32);
        for (int kt = wv; kt < ntile; kt += 8) {
            const int ktn = (kt + 8 < ntile) ? kt + 8 : kt; const bf16* kpn = kbase + (size_t)(16 * ktn) * PJ;
            const bf16x8 n0 = *(const GAS bf16x8*)kpn, n1 = *(const GAS bf16x8*)(kpn + 32);
            LAS f32x4v* sp = (LAS f32x4v*)(L + (q16 * SC_PITCH + 16 * kt + 4 * kg) * 4);
            f32x4v sc = {0.f, 0.f, 0.f, 0.f}; if (ps) sc = *sp;
            f32x4v dd[8];
#pragma unroll
            for (int h = 0; h < 8; ++h) { dd[h] = (f32x4v){0.f, 0.f, 0.f, 0.f}; dd[h] = __builtin_amdgcn_mfma_f32_16x16x32_bf16(a0, qf[h][0], dd[h], 0, 0, 0); dd[h] = __builtin_amdgcn_mfma_f32_16x16x32_bf16(a1, qf[h][1], dd[h], 0, 0, 0); }
#pragma unroll
            for (int h = 0; h < 8; ++h)
#pragma unroll
                for (int r = 0; r < 4; ++r) sc[r] += wq[h] * __builtin_amdgcn_fmed3f(dd[h][r], 0.f, finf);
            *sp = sc;
            if (ps) {
#pragma unroll
                for (int r = 0; r < 4; ++r) { const int bk = (int)fminf(fmaxf(sc[r] * 16.0f + 128.0f, 0.f), 255.0f); __hip_atomic_fetch_add(hq + bk, 1u, __ATOMIC_RELAXED, __HIP_MEMORY_SCOPE_WORKGROUP); } }
            a0 = n0; a1 = n1;
        }
    }
    __syncthreads();
    const int nblk = c + 1;
    unsigned long long* MASK = (unsigned long long*)((unsigned char*)F.out + DO_MASK);
#pragma unroll 1
    for (int qq = 0; qq < 2; ++qq) { const int ql = 2 * wv + qq; const LAS float* sr = (const LAS float*)L + ql * SC_PITCH + lane;
        unsigned v[32];
        { float xv[32];
#pragma unroll
          for (int i = 0; i < 32; ++i) xv[i] = sr[64 * i];
#pragma unroll
          for (int i = 0; i < 32; ++i) { const unsigned msk = (i < nblk) ? 0xffffffffu : 0u; v[i] = ordkey(xv[i]) & msk; } }
        unsigned Lk = 0u, Hk = 0xffffffffu;
        { const v4u h4 = *(const LAS v4u*)(L + SC_HIST + ql * 1024 + lane * 16); const int s4 = (int)(h4.x + h4.y + h4.z + h4.w);
          int suf = s4;
#pragma unroll
          for (int o = 1; o < 64; o <<= 1) { const int t2 = __shfl_down(suf, o); if (lane + o < 64) suf += t2; }
          const unsigned long long mge = __ballot(suf >= 256); const int ls = 63 - __builtin_clzll(mge);
          int above = __builtin_amdgcn_readlane(suf, ls) - __builtin_amdgcn_readlane(s4, ls);
          const int hb[4] = {__builtin_amdgcn_readlane((int)h4.x, ls), __builtin_amdgcn_readlane((int)h4.y, ls), __builtin_amdgcn_readlane((int)h4.z, ls), __builtin_amdgcn_readlane((int)h4.w, ls)};
          int bstar = 4 * ls;
#pragma unroll
          for (int e = 3; e >= 0; --e) { if (above < 256 && above + hb[e] >= 256) bstar = 4 * ls + e; above += hb[e]; }
          if (bstar > 0) Lk = ordkey(((float)(bstar - 128)) * 0.0625f - 0.002f);
          if (bstar < 255) Hk = ordkey(((float)(bstar + 1 - 128)) * 0.0625f + 0.002f);
          if (Lk != 0u && count_ge(v, Lk) < 256) { Hk = Lk; Lk = 0u; }
          if (Hk != 0xffffffffu && count_ge(v, Hk) >= 256) { Lk = Hk; Hk = 0xffffffffu; }
        }
        unsigned thr = Lk; bool exact = false;
        while (Hk - Lk > 1u) { const unsigned mid = Lk + ((Hk - Lk) >> 1); const int cnt = count_ge(v, mid);
            if (cnt >= 256) { Lk = mid; if (cnt == 256) { exact = true; break; } } else Hk = mid; }
        thr = Lk;
        int need = 0;
        if (!exact) { int cgt = 0;
#pragma unroll
            for (int i = 0; i < 32; ++i) cgt += (v[i] > thr) ? 1 : 0;
            need = 256 - wave_sum_i32(cgt); }
        unsigned long long* mrow = MASK + (row0 + tq0 + ql) * 32; unsigned mlo = 0u, mhi = 0u;
        if (exact) {
#pragma unroll
            for (int i = 0; i < 32; ++i) { const unsigned long long mk = __ballot(v[i] >= thr); mlo = (lane == i) ? (unsigned)mk : mlo; mhi = (lane == i) ? (unsigned)(mk >> 32) : mhi; }
        } else {
#pragma unroll
            for (int i = 0; i < 32; ++i) { const bool eq = (v[i] == thr); const unsigned long long me = __ballot(eq); const int before = __popcll(me & ((1ull << lane) - 1ull));
                const unsigned long long mk = __ballot((v[i] > thr) || (eq && before < need)); need -= __popcll(me); if (need < 0) need = 0;
                mlo = (lane == i) ? (unsigned)mk : mlo; mhi = (lane == i) ? (unsigned)(mk >> 32) : mhi; }
        }
        if (lane < nblk) mrow[lane] = (unsigned long long)mlo | ((unsigned long long)mhi << 32);
    }
    __syncthreads();
}
#ifndef DSA_EARLY_STOP
#define DSA_EARLY_STOP 0
#endif
typedef short bf16x8s __attribute__((ext_vector_type(8)));
constexpr int CW_ATTNQ = 2048;
__device__ __forceinline__ float wave_min_f32(float x) {
#pragma unroll
    for (int o = 1; o < 64; o <<= 1) x = fminf(x, __shfl_xor(x, o));
    return x;
}
__device__ __forceinline__ void dsa_attn_item(Frame& F, int b, int item, float smax2) {
    const int lane = F.lane, l31 = lane & 31, hi = lane >> 5;
    const int c = 31 - (item >> 4), rem = item & 15, h = 7 - (rem >> 1), qt = rem & 1;
    const size_t row0 = (size_t)b * T; const int t0 = 64 * c, tq = t0 + 32 * qt, ntile = 2 * (c + 1);
    const bf16* PROJ = (const bf16*)(F.ws + WS_PROJ);
    const float slope2 = __builtin_amdgcn_exp2f(-(float)(h + 1)) * 1.4426950408889634f;
    bf16x8 Qf[4];
#pragma unroll
    for (int ks = 0; ks < 4; ++ks) Qf[ks] = *(const GAS bf16x8*)(PROJ + (row0 + tq + l31) * PJ + C_DQ + h * 64 + 16 * ks + 8 * hi);
    f32x16 O[2]; O[0] = (f32x16){}; O[1] = (f32x16){};
    float mrun = -1e30f, lrun = 0.f;
    const bf16* Kb = PROJ + (row0 + (size_t)h * 256) * PJ + C_GQ + lane * 8;
    const unsigned char* Vb = (const unsigned char*)F.out + DO_VT + ((size_t)(b * 8 + h) * 64) * 4096 + lane * 16;
    const unsigned* Mw = (const unsigned*)((const unsigned char*)F.out + DO_MASK) + (row0 + tq + l31) * 64;
    bf16x8 Kf[2][4]; unsigned mw[2] = {0xffffffffu, 0xffffffffu};
    { const int jp = c;
#pragma unroll
      for (int tp = 0; tp < 2; ++tp)
#pragma unroll
          for (int ks = 0; ks < 4; ++ks) Kf[tp][ks] = *(const GAS bf16x8*)(Kb + (size_t)(4 * (2 * jp + tp) + ks) * PJ);
      if (c >= 4) { const unsigned long long m2 = *(const GAS unsigned long long*)(Mw + 2 * jp); mw[0] = (unsigned)m2; mw[1] = (unsigned)(m2 >> 32); } }
    for (int jp = c; jp >= 0; --jp) {
        const int jn = jp > 0 ? jp - 1 : 0;
        bf16x8 Vf[2][2][2], Kn[2][4]; unsigned mwn[2] = {0xffffffffu, 0xffffffffu};
#pragma unroll
        for (int tp = 0; tp < 2; ++tp)
#pragma unroll
            for (int dt = 0; dt < 2; ++dt)
#pragma unroll
                for (int s = 0; s < 2; ++s) Vf[tp][dt][s] = *(const GAS bf16x8*)(Vb + (size_t)(2 * jp + tp) * 4096 + (dt * 2 + s) * 1024);
#pragma unroll
        for (int tp = 0; tp < 2; ++tp)
#pragma unroll
            for (int ks = 0; ks < 4; ++ks) Kn[tp][ks] = *(const GAS bf16x8*)(Kb + (size_t)(4 * (2 * jn + tp) + ks) * PJ);
        if (c >= 4) { const unsigned long long m2 = *(const GAS unsigned long long*)(Mw + 2 * jn); mwn[0] = (unsigned)m2; mwn[1] = (unsigned)(m2 >> 32); }
        f32x16 S[2]; S[0] = (f32x16){}; S[1] = (f32x16){};
#pragma unroll
        for (int ks = 0; ks < 4; ++ks) { S[0] = __builtin_amdgcn_mfma_f32_32x32x16_bf16(Kf[0][ks], Qf[ks], S[0], 0, 0, 0); S[1] = __builtin_amdgcn_mfma_f32_32x32x16_bf16(Kf[1][ks], Qf[ks], S[1], 0, 0, 0); }
        float mt = -INFINITY;
#pragma unroll
        for (int tp = 0; tp < 2; ++tp) { const float dq = (float)(tq + l31 - 32 * (2 * jp + tp) - 4 * hi); const unsigned wsh = mw[tp] >> (4 * hi);
#pragma unroll
            for (int r = 0; r < 16; ++r) { const int cr = (r & 3) + 8 * (r >> 2); float x = S[tp][r] - slope2 * fabsf(dq - (float)cr); x = ((wsh >> cr) & 1u) ? x : -INFINITY; S[tp][r] = x; mt = fmaxf(mt, x); } }
        { const auto rr = __builtin_amdgcn_permlane32_swap(__float_as_uint(mt), __float_as_uint(mt), false, false); mt = fmaxf(__uint_as_float(rr[0]), __uint_as_float(rr[1])); }
        const float mnew = fmaxf(mrun, mt), alpha = __builtin_amdgcn_exp2f(mrun - mnew); const bool grew = mnew > mrun; mrun = mnew;
        float ls = 0.f;
#pragma unroll
        for (int tp = 0; tp < 2; ++tp)
#pragma unroll
            for (int r = 0; r < 16; ++r) { S[tp][r] = __builtin_amdgcn_exp2f(S[tp][r] - mnew); ls += S[tp][r]; }
        lrun = lrun * alpha + ls;
        bf16x8 P[2][2];
#pragma unroll
        for (int tp = 0; tp < 2; ++tp) { unsigned pw[8];
#pragma unroll
            for (int j = 0; j < 8; ++j) pw[j] = cvtpk(S[tp][2 * j], S[tp][2 * j + 1]);
            P[tp][0] = __builtin_bit_cast(bf16x8, (v4u){pw[0], pw[1], pw[2], pw[3]}); P[tp][1] = __builtin_bit_cast(bf16x8, (v4u){pw[4], pw[5], pw[6], pw[7]}); }
        if (__any(grew)) {
#pragma unroll
            for (int dt = 0; dt < 2; ++dt)
#pragma unroll
                for (int r = 0; r < 16; ++r) O[dt][r] *= alpha; }
#pragma unroll
        for (int tp = 0; tp < 2; ++tp)
#pragma unroll
            for (int s = 0; s < 2; ++s) { O[0] = __builtin_amdgcn_mfma_f32_32x32x16_bf16(Vf[tp][0][s], P[tp][s], O[0], 0, 0, 0); O[1] = __builtin_amdgcn_mfma_f32_32x32x16_bf16(Vf[tp][1][s], P[tp][s], O[1], 0, 0, 0); }
#if DSA_EARLY_STOP
        if (jp > 0) { const float dmin = (float)(tq - 64 * jp + 1);
            if (!__any(slope2 * dmin < smax2 - mrun + 51.0f)) break; }
#endif
#pragma unroll
        for (int tp = 0; tp < 2; ++tp)
#pragma unroll
            for (int ks = 0; ks < 4; ++ks) Kf[tp][ks] = Kn[tp][ks];
        mw[0] = mwn[0]; mw[1] = mwn[1];
    }
    bf16* YMIX = (bf16*)(F.ws + WS_YMIX);
    const float lt = lrun + __shfl_xor(lrun, 32), inv = __builtin_amdgcn_rcpf(lt);
    bf16* yp = YMIX + (row0 + tq + l31) * D + 512 + h * 64 + 4 * hi;
#pragma unroll
    for (int dt = 0; dt < 2; ++dt)
#pragma unroll
        for (int g = 0; g < 4; ++g) *(GAS unsigned long long*)(yp + 32 * dt + 8 * g) = (unsigned long long)cvtpk(O[dt][4 * g] * inv, O[dt][4 * g + 1] * inv) | ((unsigned long long)cvtpk(O[dt][4 * g + 2] * inv, O[dt][4 * g + 3] * inv) << 32);
}
__device__ __forceinline__ void dsa_attn_phase(Frame& F) {
    float gq = fabsf(F.in[I_GQD][F.lane]), gk = fabsf(F.in[I_GKD][F.lane]);
#pragma unroll
    for (int o = 1; o < 64; o <<= 1) { gq = fmaxf(gq, __shfl_xor(gq, o)); gk = fmaxf(gk, __shfl_xor(gk, o)); }
    const float smax2 = 64.0f * gq * gk * DSA_QSCALE * 1.001f;
    const int x0 = (int)(xb_xcc_id() & 7u);
    for (int k = 0; k < 8; ++k) { const int bq = (x0 + k) & 7; unsigned* qh = (unsigned*)(F.ctl + CW_ATTNQ + 64 * bq);
        for (;;) { int item = 0; if (F.lane == 0) item = (int)__hip_atomic_fetch_add(qh, 1u, __ATOMIC_RELAXED, __HIP_MEMORY_SCOPE_AGENT);
            item = __builtin_amdgcn_readfirstlane(item); if (item >= NCH * 8 * 2) break;
            dsa_attn_item(F, bq, item, smax2); } }
}
constexpr float XA_QSCALE = 0.08838834764831845f * 1.4426950408889634f;
__device__ __forceinline__ void xattn_unit(Frame& F, int u) {
    const int tid = F.tid, lane = F.lane, wv = F.wave, l31 = lane & 31, hi = lane >> 5;
    const int tt = u >> 2, hx = u & 3, b = tt >> 3; LAS unsigned char* L = F.lds;
    const bf16* KM = (const bf16*)(F.ws + WS_KM); const bf16* VTM = (const bf16*)(F.ws + WS_VTM); const bf16* XQ = (const bf16*)(F.ws + WS_XQ); bf16* XO = (bf16*)(F.ws + WS_XO);
    {
        const int key = tid >> 1, hf = tid & 1; const bf16* kp = KM + ((size_t)b * NMEM + key) * 512 + hx * 128 + hf * 64; const float* g = F.in[I_GXK] + hf * 64;
        unsigned rw[32]; float ss = 0.f;
#pragma unroll
        for (int q = 0; q < 8; ++q) { const v4u r4 = *(const GAS v4u*)(kp + 8 * q); rw[4 * q] = r4.x; rw[4 * q + 1] = r4.y; rw[4 * q + 2] = r4.z; rw[4 * q + 3] = r4.w; }
#pragma unroll
        for (int j = 0; j < 32; ++j) { const float a = bflo(rw[j]), c2 = bfhi(rw[j]); ss += a * a + c2 * c2; }
        ss += __shfl_xor(ss, 1);
        const float rs = __builtin_amdgcn_rsqf(ss * (1.0f / 128.0f) + 1e-6f);
#pragma unroll
        for (int q = 0; q < 8; ++q) { unsigned o[4];
#pragma unroll
            for (int j = 0; j < 4; ++j) o[j] = cvtpk(bflo(rw[4 * q + j]) * rs * g[8 * q + 2 * j], bfhi(rw[4 * q + j]) * rs * g[8 * q + 2 * j + 1]);
            const int d0 = hf * 64 + 8 * q;
            *(LAS v4u*)(L + ((key >> 5) * 8 + (d0 >> 4)) * 1024 + ((key & 31) + 32 * ((d0 >> 3) & 1)) * 16) = (v4u){o[0], o[1], o[2], o[3]}; }
    }
    {
        const int d = tid >> 2, qr = tid & 3; const bf16* vp = VTM + ((size_t)hx * 128 + d) * MMEM + (size_t)b * NMEM + qr * 64;
#pragma unroll
        for (int s4 = 0; s4 < 4; ++s4) { const v4u a = *(const GAS v4u*)(vp + 16 * s4), c4 = *(const GAS v4u*)(vp + 16 * s4 + 8);
            const int s = qr * 4 + s4; LAS unsigned char* fp = L + 65536 + ((d >> 5) * 16 + s) * 1024 + (d & 31) * 16;
            *(LAS v4u*)fp = (v4u){a.x, a.y, c4.x, c4.y};
            *(LAS v4u*)(fp + 512) = (v4u){a.z, a.w, c4.z, c4.w}; }
    }
    const size_t row = (size_t)tt * 256 + 32 * wv + l31;
    bf16x8 Qf[8];
    { const bf16* qp = XQ + row * 512 + hx * 128 + 8 * hi; unsigned rw[32]; float ss = 0.f;
#pragma unroll
      for (int ks = 0; ks < 8; ++ks) { const v4u r4 = *(const GAS v4u*)(qp + 16 * ks); rw[4 * ks] = r4.x; rw[4 * ks + 1] = r4.y; rw[4 * ks + 2] = r4.z; rw[4 * ks + 3] = r4.w; }
#pragma unroll
      for (int j = 0; j < 32; ++j) { const float a = bflo(rw[j]), c2 = bfhi(rw[j]); ss += a * a + c2 * c2; }
      ss += __shfl_xor(ss, 32);
      const float rs = __builtin_amdgcn_rsqf(ss * (1.0f / 128.0f) + 1e-6f) * XA_QSCALE; const float* g = F.in[I_GXQ] + 8 * hi;
#pragma unroll
      for (int ks = 0; ks < 8; ++ks) { unsigned o[4];
#pragma unroll
          for (int j = 0; j < 4; ++j) o[j] = cvtpk(bflo(rw[4 * ks + j]) * rs * g[16 * ks + 2 * j], bfhi(rw[4 * ks + j]) * rs * g[16 * ks + 2 * j + 1]);
          Qf[ks] = __builtin_bit_cast(bf16x8, (v4u){o[0], o[1], o[2], o[3]}); } }
    __syncthreads();
    f32x16 O[4];
#pragma unroll
    for (int dt = 0; dt < 4; ++dt) O[dt] = (f32x16){};
    float mrun = -1e30f, lrun = 0.f;
#pragma unroll 1
    for (int kt = 0; kt < 8; ++kt) {
        f32x16 S = {};
#pragma unroll
        for (int ks = 0; ks < 8; ++ks) S = __builtin_amdgcn_mfma_f32_32x32x16_bf16(*(const LAS bf16x8*)(L + (kt * 8 + ks) * 1024 + lane * 16), Qf[ks], S, 0, 0, 0);
        float mt = S[0];
#pragma unroll
        for (int r = 1; r < 16; ++r) mt = fmaxf(mt, S[r]);
        mt = fmaxf(mt, __shfl_xor(mt, 32));
        const float mnew = fmaxf(mrun, mt), alpha = __builtin_amdgcn_exp2f(mrun - mnew); mrun = mnew; float ls = 0.f;
#pragma unroll
        for (int r = 0; r < 16; ++r) { S[r] = __builtin_amdgcn_exp2f(S[r] - mnew); ls += S[r]; }
        lrun = lrun * alpha + ls;
        unsigned pw[8];
#pragma unroll
        for (int j = 0; j < 8; ++j) pw[j] = cvtpk(S[2 * j], S[2 * j + 1]);
        const bf16x8 P0 = __builtin_bit_cast(bf16x8, (v4u){pw[0], pw[1], pw[2], pw[3]}), P1 = __builtin_bit_cast(bf16x8, (v4u){pw[4], pw[5], pw[6], pw[7]});
#pragma unroll
        for (int dt = 0; dt < 4; ++dt) {
#pragma unroll
            for (int r = 0; r < 16; ++r) O[dt][r] *= alpha;
            O[dt] = __builtin_amdgcn_mfma_f32_32x32x16_bf16(*(const LAS bf16x8*)(L + 65536 + (dt * 16 + 2 * kt) * 1024 + lane * 16), P0, O[dt], 0, 0, 0);
            O[dt] = __builtin_amdgcn_mfma_f32_32x32x16_bf16(*(const LAS bf16x8*)(L + 65536 + (dt * 16 + 2 * kt + 1) * 1024 + lane * 16), P1, O[dt], 0, 0, 0); }
    }
    const float lt = lrun + __shfl_xor(lrun, 32), inv = __builtin_amdgcn_rcpf(lt);
    bf16* op = XO + row * 512 + hx * 128 + 4 * hi;
#pragma unroll
    for (int dt = 0; dt < 4; ++dt)
#pragma unroll
        for (int g = 0; g < 4; ++g) *(GAS unsigned long long*)(op + 32 * dt + 8 * g) = (unsigned long long)cvtpk(O[dt][4 * g] * inv, O[dt][4 * g + 1] * inv) | ((unsigned long long)cvtpk(O[dt][4 * g + 2] * inv, O[dt][4 * g + 3] * inv) << 32);
    __syncthreads();
}
struct Args { const float* in[21]; float* out; unsigned char* ws; int ph_lo, ph_hi, li, pad; };
__global__ void __launch_bounds__(NWAVES * 64, 2) mega(Args args) {
    extern __shared__ __attribute__((aligned(16))) unsigned char lds[];
    Frame F;
    F.lds = (LAS unsigned char*)lds;
    F.MISC = (volatile LAS unsigned*)(F.lds + MISC_OFF);
    F.tid = threadIdx.x; F.lane = F.tid & 63; F.wave = __builtin_amdgcn_readfirstlane(F.tid >> 6);
    F.G = gridDim.x; { const int bx = blockIdx.x; F.vcu = (F.G % 8 == 0) ? (bx % 8) * (F.G / 8) + bx / 8 : bx; }
    unsigned char* ws = args.ws; F.ws = ws; F.out = args.out;
    F.ctl = (gu32*)(ws + WS_CTL);
#pragma unroll
    for (int i = 0; i < 21; ++i) F.in[i] = args.in[i];
    for (int u = F.tid; u < (LDS_BYTES - LDSCTL_OFF) / 4; u += NWAVES * 64) ((LAS unsigned*)(F.lds + LDSCTL_OFF))[u] = 0u;
    __syncthreads();
    const int lo = args.ph_lo, hi = args.ph_hi;
    XcdBarrier bar; bar.bar = (unsigned*)(F.ctl + CW_BAR) + args.li * XCD_BAR_WORDS; bar.x = 0; bar.st = nullptr;
    if (hi - lo > 1) bar = xcd_barrier_post((unsigned*)(F.ctl + CW_BAR) + args.li * XCD_BAR_WORDS, F.MISC + 8);
#define IN(k) (lo <= (k) && (k) < hi)
#define BOTH(k) (IN(k) && IN((k) + 1))
#define GRID_BAR() xcd_barrier(bar)
    if (IN(0)) { p0_prologue(F); if (BOTH(0)) GRID_BAR(); }
    if (IN(1)) {
        pg8::Gemm g{(const pg8::bf16_t*)(ws + WS_XB), (const pg8::bf16_t*)(ws + WS_WIN), M, NIN_PAD, D}; pg8::StaticOrder S; S.init(M, NIN_PAD, F.G, (int)blockIdx.x);
        pg8::EpiScale E{(pg8::bf16_t*)(ws + WS_PROJ), PJ, (const float*)(ws + WS_SSQ0), NIN, (int)((size_t)M * PJ * 2)};
        pg8::gemm_phase<pg8::EpiScale, pg8::StaticOrder, true, true>(F.lds + RING_OFF, g, S, E);
        if (BOTH(1)) GRID_BAR();
    }
    if (IN(2)) {
        for (int it = blockIdx.x; it < BATCH * 4 * NCH; it += F.G) gdn_prep_item(F, it);
        for (int u = blockIdx.x; u < BATCH * NCH; u += F.G) dsa_norm_unit(F, u);
        for (int u = blockIdx.x; u < 256; u += F.G) dsa_index_unit(F, (u >> 2) & 7, 4 + (u >> 5), u & 3);
        GRID_BAR();
        if (blockIdx.x < 32) gdn_scan_bh(F, (int)blockIdx.x);
        else { const int w = (int)blockIdx.x - 32, nw = F.G - 32;
               for (int r = 0; ; ++r) { const int pos = (r & 1) ? (r + 1) * nw - 1 - w : r * nw + w; if (r * nw >= 640) break; if (pos >= 640) continue;
                   dsa_index_unit(F, (pos >> 2) & 7, 31 - (pos >> 5), pos & 3); } }
        if (BOTH(2)) GRID_BAR();
    }
    if (IN(3)) {
        dsa_attn_phase(F);
        if (BOTH(3)) GRID_BAR();
    }
    if (IN(4)) {
        pg8::Gemm g{(const pg8::bf16_t*)(ws + WS_YMIX), (const pg8::bf16_t*)(ws + WS_WOUT), M, D, D}; pg8::StaticOrder S; S.init(M, D, F.G, (int)blockIdx.x);
        typedef pg8::EpiRes<false, false, true> Epi4; Epi4 E{F.in[I_X], nullptr, (pg8::bf16_t*)(ws + WS_XB), (float*)(ws + WS_SSQ1), D};
        pg8::gemm_phase<Epi4, pg8::StaticOrder, true, true>(F.lds + RING_OFF, g, S, E);
        if (BOTH(4)) GRID_BAR();
    }
    if (IN(5)) {
        { pg8::Gemm g{(const pg8::bf16_t*)(ws + WS_XB), (const pg8::bf16_t*)(ws + WS_WXQ), M, 512, D}; pg8::StaticOrder S; S.init(M, 512, F.G, (int)blockIdx.x);
          pg8::EpiScale E{(pg8::bf16_t*)(ws + WS_XQ), 512, (const float*)(ws + WS_SSQ1), 512, 0};
          pg8::gemm_phase<pg8::EpiScale, pg8::StaticOrder, true, true>(F.lds + RING_OFF, g, S, E); }
        { pg8::Gemm g{(const pg8::bf16_t*)(ws + WS_MEMB), (const pg8::bf16_t*)(ws + WS_WXKV), MMEM, 512, D}; pg8::StaticOrder S; S.init(MMEM, 512, F.G, ((int)blockIdx.x + F.G - 128) % F.G);
          pg8::EpiScale E{(pg8::bf16_t*)(ws + WS_KM), 512, (const float*)(ws + WS_SSQM), 512, 0};
          pg8::gemm_phase<pg8::EpiScale, pg8::StaticOrder, true, true>(F.lds + RING_OFF, g, S, E); }
        { pg8::Gemm g{(const pg8::bf16_t*)(ws + WS_WXKV) + (size_t)512 * D, (const pg8::bf16_t*)(ws + WS_MEMB), 512, MMEM, D}; pg8::StaticOrder S; S.init(512, MMEM, F.G, ((int)blockIdx.x + F.G - 144) % F.G);
          pg8::EpiScaleCol E{(pg8::bf16_t*)(ws + WS_VTM), MMEM, (const float*)(ws + WS_SSQM)};
          pg8::gemm_phase<pg8::EpiScaleCol, pg8::StaticOrder, true, true>(F.lds + RING_OFF, g, S, E); }
        if ((int)blockIdx.x >= 160) p0_transposes(F, TR_EARLY, TR_ALL, ((int)blockIdx.x - 160) * NWAVES + F.wave, (F.G - 160) * NWAVES);
        if (BOTH(5)) GRID_BAR();
    }
    if (IN(6)) {
        for (int u = blockIdx.x; u < (M / 256) * 4; u += F.G) xattn_unit(F, u);
        if (BOTH(6)) GRID_BAR();
    }
    if (IN(7)) {
        pg8::Gemm g{(const pg8::bf16_t*)(ws + WS_XO), (const pg8::bf16_t*)(ws + WS_WXO), M, D, 512}; pg8::StaticOrder S; S.init(M, D, F.G, (int)blockIdx.x);
        typedef pg8::EpiRes<true, false, true> Epi7; Epi7 E{ws + WS_XB, nullptr, (pg8::bf16_t*)(ws + WS_XB), (float*)(ws + WS_SSQ2), D};
        pg8::gemm_phase<Epi7, pg8::StaticOrder, true, true>(F.lds + RING_OFF, g, S, E);
        if (BOTH(7)) GRID_BAR();
    }
    if (IN(8)) {
        pg8::Gemm g{(const pg8::bf16_t*)(ws + WS_XB), (const pg8::bf16_t*)(ws + WS_WGU), M, 2 * DFF, D}; pg8::StaticOrder S; S.init(M, 2 * DFF, F.G, (int)blockIdx.x);
        pg8::EpiSwiglu E{(pg8::bf16_t*)(ws + WS_ACT), DFF, (const float*)(ws + WS_SSQ2), (int)((size_t)M * DFF * 2)};
        pg8::gemm_phase<pg8::EpiSwiglu, pg8::StaticOrder, true, true>(F.lds + RING_OFF, g, S, E);
        if (BOTH(8)) GRID_BAR();
    }
    if (IN(9)) {
        pg8::Gemm g{(const pg8::bf16_t*)(ws + WS_ACT), (const pg8::bf16_t*)(ws + WS_WDOWN), M, D, DFF}; pg8::StaticOrder S; S.init(M, D, F.G, (int)blockIdx.x);
        typedef pg8::EpiRes<true, true, false> Epi9; Epi9 E{ws + WS_XB, F.out, nullptr, nullptr, D};
        pg8::gemm_phase<Epi9, pg8::StaticOrder, true, true>(F.lds + RING_OFF, g, S, E);
    }
#undef IN
#undef BOTH
}
}
extern "C" void kernel_launch(void* const* d_in, const int* in_sizes, int n_in, void* d_out, int out_size, void* d_ws, size_t ws_size, hipStream_t stream) {
  static int grid = 0;
  if (grid == 0) {
    int dev = 0, cus = 0, per_cu = 0;
    (void)hipFuncSetAttribute((const void*)mk::mega, hipFuncAttributeMaxDynamicSharedMemorySize, mk::LDS_BYTES);
    if (hipGetDevice(&dev) != hipSuccess || hipDeviceGetAttribute(&cus, hipDeviceAttributeMultiprocessorCount, dev) != hipSuccess || cus <= 0) cus = 256;
    if (hipOccupancyMaxActiveBlocksPerMultiprocessor(&per_cu, (const void*)mk::mega, mk::NWAVES * 64, mk::LDS_BYTES) != hipSuccess || per_cu < 1) { fprintf(stderr, "kernel_launch: occupancy query reports %d workgroups per CU\n", per_cu); per_cu = 1; }
    (void)hipGetLastError();
    grid = cus;
  }
  (void)hipMemsetAsync((char*)d_ws + mk::WS_CTL, 0, mk::CTL_ZERO_BYTES, stream);
  mk::Args a{}; for (int i = 0; i < 21; ++i) a.in[i] = (const float*)d_in[i]; a.out = (float*)d_out; a.ws = (unsigned char*)d_ws;
  a.ph_lo = 0; a.ph_hi = 10; a.li = 0;
  void* args[] = {&a};
  const hipError_t e = hipLaunchCooperativeKernel((const void*)mk::mega, dim3(grid), dim3(mk::NWAVES * 64), args, mk::LDS_BYTES, stream);
  if (e != hipSuccess) fprintf(stderr, "kernel_launch: cooperative launch failed: %s (grid %d)\n", hipGetErrorString(e), grid);
}
```

```cpp
#include <hip/hip_runtime.h>
#include <cstdio>
#include <cstdint>
namespace pg8 {
#define PG8_LAS __attribute__((address_space(3)))
typedef unsigned short bf16_t;
typedef short bf16x8 __attribute__((ext_vector_type(8)));
typedef float f32x4 __attribute__((ext_vector_type(4)));
typedef unsigned u32x4 __attribute__((ext_vector_type(4)));
constexpr int BM = 256, BK = 64, HALF = 128, HTB = HALF * BK * 2  , STAGE_BYTES = 8 * HTB, NXCD = 8, WGM = 8;

__host__ __device__ __forceinline__ int lds_byte(int r, int c) { const int st = (r >> 4) * 2 + (c >> 5), rr = r & 15, cc = c & 31, ob = rr * 64 + cc * 2; return st * 1024 + (ob ^ (((ob >> 9) & 1) << 5)); }
__host__ __device__ __forceinline__ void stage_rc(int b, int& R, int& C) { const int st = b / 1024, sb = b % 1024, swz = sb ^ (((sb >> 9) & 1) << 5); R = (st >> 1) * 16 + swz / 64; C = (st & 1) * 32 + (swz % 64) / 2; }
__host__ __device__ __forceinline__ int perm32(int rho) { const int n = rho >> 4, i = rho & 15; return 8 * (i >> 2) + 4 * n + (i & 3); }

struct Unit { int pm, pn; };
struct Gemm { const bf16_t* A; const bf16_t* Bt; int M, N, K; };

struct StaticOrder {
    int nM, nN, nwg, G, c;
    __host__ __device__ void init(int M, int N, int G_, int c_) { nM = M / BM; nN = N / BM; nwg = nM * nN; G = G_; c = c_; }
    __host__ __device__ bool next(int i, Unit& u) const {
        const long L = (long)i * G + c; if (L >= nwg) return false;
        int wgid = (int)L; { const int q = nwg / NXCD, r = nwg % NXCD, xcd = wgid % NXCD, off = wgid / NXCD; wgid = (xcd < r ? xcd * (q + 1) : r * (q + 1) + (xcd - r) * q) + off; }
        const int nig = WGM * nN, gid = wgid / nig, fm = gid * WGM, gsz = (nM - fm) < WGM ? (nM - fm) : WGM;
        u.pm = fm + ((wgid % nig) % gsz); u.pn = (wgid % nig) / gsz; return true;
    }
    __device__ __forceinline__ void a_ready(const Unit&) const {}
    __device__ __forceinline__ void done(const Unit&) const {}
};

__device__ __forceinline__ unsigned cvt_pk_bf16(float lo, float hi) { unsigned r; asm volatile("v_cvt_pk_bf16_f32 %0, %1, %2" : "=v"(r) : "v"(lo), "v"(hi)); return r; }
constexpr float RMS_EPS = 1e-6f;
struct EpiScale {
    static constexpr bool PERM = true, AFTER_DRAIN = false;
    bf16_t* O; int ldc; const float* ssq; int nvalid; int wt_bytes;
    __device__ __forceinline__ void operator()(const f32x4 (&acc)[2][2][4][2], const Unit& u, int wr, int wc, int fr, int fq) const {
        const int row0 = u.pm * BM + wr * 64 + fr, col0 = u.pn * BM + wc * 32 + 8 * fq;
        const __amdgpu_buffer_rsrc_t rsrc = __builtin_amdgcn_make_buffer_rsrc(O, 0, wt_bytes, 0x00020000);
#pragma unroll
        for (int ai = 0; ai < 2; ++ai)
#pragma unroll
            for (int m = 0; m < 4; ++m) { const int row = row0 + ai * HALF + m * 16; const float rs = __builtin_amdgcn_rsqf(ssq[row] * (1.0f / 1024.0f) + RMS_EPS);
                bf16_t* rowp = O + (size_t)row * ldc + col0;
#pragma unroll
                for (int bj = 0; bj < 2; ++bj) if (col0 + bj * HALF < nvalid) { const f32x4 v0 = acc[ai][bj][m][0] * rs, v1 = acc[ai][bj][m][1] * rs;
                    u32x4 w; w.x = cvt_pk_bf16(v0[0], v0[1]); w.y = cvt_pk_bf16(v0[2], v0[3]); w.z = cvt_pk_bf16(v1[0], v1[1]); w.w = cvt_pk_bf16(v1[2], v1[3]);
                    if (wt_bytes > 0) __builtin_amdgcn_raw_buffer_store_b128(w, rsrc, (int)(((size_t)row * ldc + col0 + bj * HALF) * 2), 0, 16);
                    else *(u32x4*)(rowp + bj * HALF) = w; } }
    }
};
struct EpiScaleCol {
    static constexpr bool PERM = true, AFTER_DRAIN = false;
    bf16_t* O; int ldc; const float* ssq;
    __device__ __forceinline__ void operator()(const f32x4 (&acc)[2][2][4][2], const Unit& u, int wr, int wc, int fr, int fq) const {
        const int row0 = u.pm * BM + wr * 64 + fr, col0 = u.pn * BM + wc * 32 + 8 * fq;
#pragma unroll
        for (int bj = 0; bj < 2; ++bj) { f32x4 s0 = *(const f32x4*)(ssq + col0 + bj * HALF), s1 = *(const f32x4*)(ssq + col0 + bj * HALF + 4);
#pragma unroll
            for (int e = 0; e < 4; ++e) { s0[e] = __builtin_amdgcn_rsqf(s0[e] * (1.0f / 1024.0f) + RMS_EPS); s1[e] = __builtin_amdgcn_rsqf(s1[e] * (1.0f / 1024.0f) + RMS_EPS); }
#pragma unroll
            for (int ai = 0; ai < 2; ++ai)
#pragma unroll
                for (int m = 0; m < 4; ++m) { const int row = row0 + ai * HALF + m * 16; const f32x4 v0 = acc[ai][bj][m][0] * s0, v1 = acc[ai][bj][m][1] * s1;
                    u32x4 w; w.x = cvt_pk_bf16(v0[0], v0[1]); w.y = cvt_pk_bf16(v0[2], v0[3]); w.z = cvt_pk_bf16(v1[0], v1[1]); w.w = cvt_pk_bf16(v1[2], v1[3]);
                    *(u32x4*)(O + (size_t)row * ldc + col0 + bj * HALF) = w; } }
    }
};
template <bool BASE_BF16, bool OUT_F32, bool OUT_BF16> struct EpiRes {
    static constexpr bool PERM = true, AFTER_DRAIN = false;
    const void* base; float* out; bf16_t* xb; float* ssq; int ldc;
    __device__ __forceinline__ void operator()(const f32x4 (&acc)[2][2][4][2], const Unit& u, int wr, int wc, int fr, int fq) const {
        const int row0 = u.pm * BM + wr * 64 + fr, col0 = u.pn * BM + wc * 32 + 8 * fq;
#pragma unroll
        for (int ai = 0; ai < 2; ++ai)
#pragma unroll
            for (int m = 0; m < 4; ++m) { const int row = row0 + ai * HALF + m * 16; const size_t off = (size_t)row * ldc + col0; float part = 0.f;
#pragma unroll
                for (int bj = 0; bj < 2; ++bj) { f32x4 b0, b1;
                    if (BASE_BF16) { const u32x4 r = *(const u32x4*)((const bf16_t*)base + off + bj * HALF);
                        b0 = (f32x4){__builtin_bit_cast(float, r.x << 16), __builtin_bit_cast(float, r.x & 0xffff0000u), __builtin_bit_cast(float, r.y << 16), __builtin_bit_cast(float, r.y & 0xffff0000u)};
                        b1 = (f32x4){__builtin_bit_cast(float, r.z << 16), __builtin_bit_cast(float, r.z & 0xffff0000u), __builtin_bit_cast(float, r.w << 16), __builtin_bit_cast(float, r.w & 0xffff0000u)}; }
                    else { b0 = *(const f32x4*)((const float*)base + off + bj * HALF); b1 = *(const f32x4*)((const float*)base + off + bj * HALF + 4); }
                    const f32x4 v0 = acc[ai][bj][m][0] + b0, v1 = acc[ai][bj][m][1] + b1;
                    if (OUT_F32) { *(f32x4*)(out + off + bj * HALF) = v0; *(f32x4*)(out + off + bj * HALF + 4) = v1; }
                    if (OUT_BF16) { u32x4 w; w.x = cvt_pk_bf16(v0[0], v0[1]); w.y = cvt_pk_bf16(v0[2], v0[3]); w.z = cvt_pk_bf16(v1[0], v1[1]); w.w = cvt_pk_bf16(v1[2], v1[3]); *(u32x4*)(xb + off + bj * HALF) = w; }
                    part += (v0[0] * v0[0] + v0[1] * v0[1]) + (v0[2] * v0[2] + v0[3] * v0[3]) + (v1[0] * v1[0] + v1[1] * v1[1]) + (v1[2] * v1[2] + v1[3] * v1[3]); }
                if (ssq) { part += __shfl_xor(part, 16); part += __shfl_xor(part, 32); if (fq == 0) atomicAdd(ssq + row, part); } }
    }
};
struct EpiSwiglu {
    static constexpr bool PERM = true, AFTER_DRAIN = false;
    bf16_t* O; int ldc; const float* ssq; int wt_bytes;
    __device__ __forceinline__ void operator()(const f32x4 (&acc)[2][2][4][2], const Unit& u, int wr, int wc, int fr, int fq) const {
        const int row0 = u.pm * BM + wr * 64 + fr, col0 = u.pn * HALF + wc * 32 + 8 * fq;
        const __amdgpu_buffer_rsrc_t rsrc = __builtin_amdgcn_make_buffer_rsrc(O, 0, wt_bytes, 0x00020000);
#pragma unroll
        for (int ai = 0; ai < 2; ++ai)
#pragma unroll
            for (int m = 0; m < 4; ++m) { const int row = row0 + ai * HALF + m * 16; const float rs = __builtin_amdgcn_rsqf(ssq[row] * (1.0f / 1024.0f) + RMS_EPS);
                float a[8];
#pragma unroll
                for (int n = 0; n < 2; ++n)
#pragma unroll
                    for (int e = 0; e < 4; ++e) { const float g = acc[ai][0][m][n][e] * rs, up = acc[ai][1][m][n][e] * rs;
                        a[n * 4 + e] = g * __builtin_amdgcn_rcpf(1.0f + __builtin_amdgcn_exp2f(g * -1.4426950408889634f)) * up; }
                u32x4 w; w.x = cvt_pk_bf16(a[0], a[1]); w.y = cvt_pk_bf16(a[2], a[3]); w.z = cvt_pk_bf16(a[4], a[5]); w.w = cvt_pk_bf16(a[6], a[7]);
                if (wt_bytes > 0) __builtin_amdgcn_raw_buffer_store_b128(w, rsrc, (int)(((size_t)row * ldc + col0) * 2), 0, 16);
                else *(u32x4*)(O + (size_t)row * ldc + col0) = w; }
    }
};
template <class Epi, class Sched, bool ALIGN_EPI = false, bool SP2 = false>
__device__ __forceinline__ void gemm_phase(PG8_LAS unsigned char* lds, const Gemm g, const Sched& S, const Epi& E) {
    const int tid = threadIdx.x, wid = __builtin_amdgcn_readfirstlane(tid >> 6), lane = tid & 63, wr = wid >> 2, wc = wid & 3, fr = lane & 15, fq = lane >> 4;
    const int K = g.K, nt = K / BK;
    unsigned voffA[2], voffB[2];
#pragma unroll
    for (int i = 0; i < 2; ++i) { int R, C; stage_rc(tid * 16 + i * 8192, R, C); const int Rb = Epi::PERM ? ((R & ~31) + perm32(R & 31)) : R;
        voffA[i] = (unsigned)(R * K + C) * 2u; voffB[i] = (unsigned)(Rb * K + C) * 2u; }
    const size_t kstep = (size_t)(BK * 2);
    const size_t hstep = (size_t)HALF * K * 2;
    const size_t tstep = 2 * hstep;
    const unsigned ldsw = (unsigned)wid * 1024u;
    const int aoff = lds_byte(wr * 64 + fr, fq * 8), boff = lds_byte(wc * 32 + fr, fq * 8);
#define PG8_SA(b, h) (((b) * 2 + (h)) * HTB)
#define PG8_SB(b, h) ((4 + (b) * 2 + (h)) * HTB)
#define PG8_STAGE(bufoff, gbase, voff) do { _Pragma("unroll") for (int _i = 0; _i < 2; ++_i) \
        __builtin_amdgcn_global_load_lds((const unsigned*)((const char*)(gbase) + (voff)[_i]), (PG8_LAS unsigned*)(lds + (bufoff) + ldsw + _i * 8192), 16, 0, 0); } while (0)
#define PG8_LDA(dst, b, h) do { _Pragma("unroll") for (int m = 0; m < 4; ++m) _Pragma("unroll") for (int k = 0; k < 2; ++k) dst[m][k] = *(const PG8_LAS bf16x8*)(lds + PG8_SA(b, h) + aoff + m * 2048 + k * 1024); } while (0)
#define PG8_LDB(dst, b, h) do { _Pragma("unroll") for (int n = 0; n < 2; ++n) _Pragma("unroll") for (int k = 0; k < 2; ++k) dst[n][k] = *(const PG8_LAS bf16x8*)(lds + PG8_SB(b, h) + boff + n * 2048 + k * 1024); } while (0)
#define PG8_MMA(ai, bj, At, Bt) do { __builtin_amdgcn_s_setprio(1); _Pragma("unroll") for (int m = 0; m < 4; ++m) _Pragma("unroll") for (int n = 0; n < 2; ++n) _Pragma("unroll") for (int k = 0; k < 2; ++k) \
        acc[ai][bj][m][n] = __builtin_amdgcn_mfma_f32_16x16x32_bf16(Bt[n][k], At[m][k], acc[ai][bj][m][n], 0, 0, 0); __builtin_amdgcn_s_setprio(0); } while (0)
#define PG8_WAIT_V(n) asm volatile("s_waitcnt vmcnt(" #n ")" ::: "memory")
#define PG8_WAIT_L(n) asm volatile("s_waitcnt lgkmcnt(" #n ")" ::: "memory")
#define PG8_BAR __builtin_amdgcn_s_barrier()
#define PG8_SCHED __builtin_amdgcn_sched_barrier(0)
    Unit cur, nxt; int ui = 0;
    if (!S.next(0, cur)) return;
    f32x4 acc[2][2][4][2];
#pragma unroll
    for (int a = 0; a < 2; ++a)
#pragma unroll
        for (int b = 0; b < 2; ++b)
#pragma unroll
            for (int m = 0; m < 4; ++m)
#pragma unroll
                for (int n = 0; n < 2; ++n) acc[a][b][m][n] = (f32x4){0.f, 0.f, 0.f, 0.f};
    bf16x8 At[4][2], B0[2][2], B1[2][2];
    const char* cA = (const char*)g.A + (size_t)cur.pm * tstep; const char* cB = (const char*)g.Bt + (size_t)cur.pn * tstep;
    S.a_ready(cur);
    if constexpr (SP2) {
        PG8_STAGE(PG8_SB(0, 0), cB, voffB); PG8_STAGE(PG8_SB(0, 1), cB + hstep, voffB); PG8_STAGE(PG8_SA(0, 0), cA, voffA); PG8_STAGE(PG8_SA(0, 1), cA + hstep, voffA);
        if (wr == 1) PG8_BAR;
        PG8_WAIT_V(2); PG8_BAR;
        PG8_STAGE(PG8_SB(1, 0), cB + kstep, voffB); PG8_STAGE(PG8_SA(1, 0), cA + kstep, voffA); PG8_STAGE(PG8_SB(1, 1), cB + hstep + kstep, voffB);
        PG8_WAIT_V(6); PG8_BAR;
    } else {
        PG8_STAGE(PG8_SB(0, 0), cB, voffB); PG8_STAGE(PG8_SA(0, 0), cA, voffA); PG8_STAGE(PG8_SB(0, 1), cB + hstep, voffB); PG8_STAGE(PG8_SA(0, 1), cA + hstep, voffA);
        if (wr == 1) PG8_BAR;
        PG8_WAIT_V(4); PG8_BAR;
        PG8_STAGE(PG8_SB(1, 0), cB + kstep, voffB); PG8_STAGE(PG8_SA(1, 0), cA + kstep, voffA); PG8_STAGE(PG8_SB(1, 1), cB + hstep + kstep, voffB);
        PG8_WAIT_V(6); PG8_BAR;
    }
    for (;;) {
        const bool has_next = S.next(ui + 1, nxt);
        const char* nA = has_next ? (const char*)g.A + (size_t)nxt.pm * tstep : cA; const char* nB = has_next ? (const char*)g.Bt + (size_t)nxt.pn * tstep : cB;
        for (int t = 0; t < nt; t += 2) {
            const bool last = (t == nt - 2);
            const char* a1 = cA + (size_t)(t + 1) * kstep;
            const char* a2 = last ? nA : cA + (size_t)(t + 2) * kstep; const char* b2 = last ? nB : cB + (size_t)(t + 2) * kstep;
            const char* a3 = a2 + kstep; const char* b3 = b2 + kstep;
            if (last && has_next) S.a_ready(nxt);
            if constexpr (SP2) {
            PG8_LDB(B0, 0, 0); PG8_LDB(B1, 0, 1); PG8_SCHED; PG8_LDA(At, 0, 0); PG8_STAGE(PG8_SA(1, 1), a1 + hstep, voffA);
            PG8_WAIT_V(8); PG8_WAIT_L(0); PG8_BAR; PG8_MMA(0, 0, At, B0); PG8_MMA(0, 1, At, B1); PG8_BAR; PG8_SCHED;
            PG8_LDA(At, 0, 1); PG8_STAGE(PG8_SB(0, 0), b2, voffB); PG8_STAGE(PG8_SB(0, 1), b2 + hstep, voffB); PG8_STAGE(PG8_SA(0, 0), a2, voffA);
            PG8_WAIT_V(8); PG8_WAIT_L(0); PG8_BAR; PG8_MMA(1, 0, At, B0); PG8_MMA(1, 1, At, B1); PG8_BAR; PG8_SCHED;
            PG8_LDB(B0, 1, 0); PG8_LDB(B1, 1, 1); PG8_SCHED; PG8_LDA(At, 1, 0); PG8_STAGE(PG8_SA(0, 1), a2 + hstep, voffA);
            PG8_WAIT_V(8); PG8_WAIT_L(0); PG8_BAR; PG8_MMA(0, 0, At, B0); PG8_MMA(0, 1, At, B1); PG8_BAR; PG8_SCHED;
            PG8_LDA(At, 1, 1); PG8_STAGE(PG8_SB(1, 0), b3, voffB); PG8_STAGE(PG8_SB(1, 1), b3 + hstep, voffB); PG8_STAGE(PG8_SA(1, 0), a3, voffA);
            PG8_WAIT_V(8); PG8_WAIT_L(0); PG8_BAR; PG8_MMA(1, 0, At, B0); PG8_MMA(1, 1, At, B1); PG8_BAR; PG8_SCHED;
            } else {
            PG8_LDB(B0, 0, 0); PG8_SCHED; PG8_LDA(At, 0, 0); PG8_STAGE(PG8_SA(1, 1), a1 + hstep, voffA);
            PG8_WAIT_L(8); PG8_BAR; PG8_WAIT_L(0); PG8_MMA(0, 0, At, B0); PG8_BAR; PG8_SCHED;
            PG8_LDB(B1, 0, 1); PG8_STAGE(PG8_SB(0, 0), b2, voffB);
            PG8_BAR; PG8_WAIT_L(0); PG8_MMA(0, 1, At, B1); PG8_BAR;
            PG8_LDA(At, 0, 1); PG8_STAGE(PG8_SA(0, 0), a2, voffA);
            PG8_BAR; PG8_WAIT_L(0); PG8_MMA(1, 0, At, B0); PG8_BAR; PG8_SCHED;
            PG8_STAGE(PG8_SB(0, 1), b2 + hstep, voffB);
            PG8_WAIT_V(6); PG8_BAR; PG8_MMA(1, 1, At, B1); PG8_BAR;
            PG8_LDB(B0, 1, 0); PG8_SCHED; PG8_LDA(At, 1, 0); PG8_STAGE(PG8_SA(0, 1), a2 + hstep, voffA);
            PG8_WAIT_L(8); PG8_BAR; PG8_WAIT_L(0); PG8_MMA(0, 0, At, B0); PG8_BAR; PG8_SCHED;
            PG8_LDB(B1, 1, 1); PG8_STAGE(PG8_SB(1, 0), b3, voffB);
            PG8_BAR; PG8_WAIT_L(0); PG8_MMA(0, 1, At, B1); PG8_BAR;
            PG8_LDA(At, 1, 1); PG8_STAGE(PG8_SA(1, 0), a3, voffA);
            PG8_BAR; PG8_WAIT_L(0); PG8_MMA(1, 0, At, B0); PG8_BAR; PG8_SCHED;
            PG8_STAGE(PG8_SB(1, 1), b3 + hstep, voffB);
            PG8_WAIT_V(6); PG8_BAR; PG8_MMA(1, 1, At, B1); PG8_BAR;
            }
        }
        if constexpr (ALIGN_EPI) { if (wr == 0) PG8_BAR; }
        if constexpr (!Epi::AFTER_DRAIN) { E(acc, cur, wr, wc, fr, fq); S.done(cur); }
        if (!has_next) break;
#pragma unroll
        for (int a = 0; a < 2; ++a)
#pragma unroll
            for (int b = 0; b < 2; ++b)
#pragma unroll
                for (int m = 0; m < 4; ++m)
#pragma unroll
                    for (int n = 0; n < 2; ++n) acc[a][b][m][n] = (f32x4){0.f, 0.f, 0.f, 0.f};
        cur = nxt; cA = nA; cB = nB; ++ui;
        if constexpr (ALIGN_EPI) { if (wr == 1) PG8_BAR; }
    }
    PG8_WAIT_V(0);
    if constexpr (!ALIGN_EPI) { if (wr == 0) PG8_BAR; }
    PG8_BAR;
    if constexpr (Epi::AFTER_DRAIN) { E.fused(acc, cur, wr, wc, fr, fq, lds, wid, lane); S.done(cur); }
#undef PG8_SA
#undef PG8_SB
#undef PG8_STAGE
#undef PG8_LDA
#undef PG8_LDB
#undef PG8_MMA
#undef PG8_WAIT_V
#undef PG8_WAIT_L
#undef PG8_BAR
#undef PG8_SCHED
}
}
namespace mk {
#define GAS __attribute__((address_space(1)))
#define LAS __attribute__((address_space(3)))
typedef unsigned short bf16;
typedef unsigned v4u __attribute__((ext_vector_type(4)));
typedef float f32x4 __attribute__((ext_vector_type(4)));
typedef short bf16x8 __attribute__((ext_vector_type(8)));
typedef GAS unsigned gu32;
typedef GAS unsigned long long gu64;
#define RLX_AGENT __ATOMIC_RELAXED, __HIP_MEMORY_SCOPE_AGENT
#define LDS_WAIT() asm volatile("s_waitcnt lgkmcnt(0)" ::: "memory")
#define VM_WAIT() asm volatile("s_waitcnt vmcnt(0)" ::: "memory")
__device__ __forceinline__ unsigned long long rt() { return __builtin_amdgcn_s_memrealtime(); }
__device__ __forceinline__ unsigned f2bf(float f) { unsigned u = __builtin_bit_cast(unsigned, f); return (u + 0x7fffu + ((u >> 16) & 1u)) >> 16; }
__device__ __forceinline__ unsigned pk2(float lo, float hi) { return f2bf(lo) | (f2bf(hi) << 16); }
#define XB_TMO      128
#define XB_XCNT(j)  (256  + 64 * (j))
#define XB_XSUB(j)  (1280 + 64 * (j))
#define XB_XGEN(j)  (2304 + 64 * (j))
#define XB_TOP      3328
#define XB_TOPGEN   3392
#define XCD_BAR_WORDS 3456
#define XB_SPIN_CAP (1u << 18)

__device__ __forceinline__ unsigned xb_ld(unsigned* p)              { return __hip_atomic_load(p, __ATOMIC_RELAXED, __HIP_MEMORY_SCOPE_AGENT); }
__device__ __forceinline__ unsigned xb_add(unsigned* p, unsigned v) { return __hip_atomic_fetch_add(p, v, __ATOMIC_RELAXED, __HIP_MEMORY_SCOPE_AGENT); }
__device__ __forceinline__ unsigned xb_xcc_id() { return (unsigned)__builtin_amdgcn_s_getreg((3 << 11) | 20) & 0xFu; }
#define XB_SPIN(cond, bar) do { unsigned _sp = 0; while (cond) { __builtin_amdgcn_s_sleep(1); \
    if ((++_sp & 255u) == 0u) { if (xb_ld(&(bar)[XB_TMO])) break; if (_sp > XB_SPIN_CAP) { atomicAdd(&(bar)[XB_TMO], 1u); break; } } } } while (0)

struct XcdBarrier {
    unsigned* bar; unsigned x;
    volatile LAS unsigned* st;
};

__device__ __forceinline__ XcdBarrier xcd_barrier_post(unsigned* bar, volatile LAS unsigned* st) {
    XcdBarrier b; b.bar = bar; b.x = xb_xcc_id(); b.st = st;
    if (threadIdx.x == 0) (void)xb_add(&bar[XB_XCNT(b.x)], 1u);
    return b;
}
__device__ __forceinline__ void xcd_barrier_complete(unsigned* bar, unsigned x, unsigned& nloc, unsigned& nx) {
    const unsigned G = gridDim.x * gridDim.y * gridDim.z;
    unsigned sum, cnt, mine, sp = 0u;
    for (;;) {
        sum = 0u; cnt = 0u; mine = 0u;
#pragma unroll
        for (unsigned j = 0; j < 16; ++j) { const unsigned c = xb_ld(&bar[XB_XCNT(j)]); sum += c; cnt += (c > 0u) ? 1u : 0u; mine = (j == x) ? c : mine; }
        if (sum == G) break;
        __builtin_amdgcn_s_sleep(1);
        if ((++sp & 255u) == 0u) { if (xb_ld(&bar[XB_TMO])) break; if (sp > XB_SPIN_CAP) { atomicAdd(&bar[XB_TMO], 1u); break; } }
    }
    nloc = mine > 0u ? mine : 1u; nx = cnt > 0u ? cnt : 1u;
}

__device__ __forceinline__ void xcd_barrier(const XcdBarrier& b) {
    asm volatile("s_waitcnt vmcnt(0)" ::: "memory");
    __syncthreads();
    if (threadIdx.x == 0) {
        unsigned* bar = b.bar;
        __builtin_amdgcn_s_waitcnt(0);
        unsigned nloc = b.st[0], nx = b.st[1];
        if (nloc == 0u) { xcd_barrier_complete(bar, b.x, nloc, nx); b.st[0] = nloc; b.st[1] = nx; }
        const unsigned old = xb_add(&bar[XB_XSUB(b.x)], 1u);
        const unsigned gen = old / nloc;
        if (old + 1u == (gen + 1u) * nloc) {
            __builtin_amdgcn_fence(__ATOMIC_RELEASE, "agent");
            asm volatile("s_waitcnt vmcnt(0)" ::: "memory");
            const unsigned og = xb_add(&bar[XB_TOP], 1u);
            const unsigned tg = og / nx;
            if (og + 1u == (tg + 1u) * nx) xb_add(&bar[XB_TOPGEN], 1u);
            else XB_SPIN(xb_ld(&bar[XB_TOPGEN]) == tg, bar);
            __builtin_amdgcn_fence(__ATOMIC_ACQUIRE, "agent");
            xb_add(&bar[XB_XGEN(b.x)], 1u);
            asm volatile("s_waitcnt vmcnt(0)" ::: "memory");
        } else {
            XB_SPIN(xb_ld(&bar[XB_XGEN(b.x)]) == gen, bar);
            __builtin_amdgcn_fence(__ATOMIC_ACQUIRE, "agent");
            asm volatile("s_waitcnt vmcnt(0)" ::: "memory");
        }
    }
    __syncthreads();
}
constexpr int NWAVES = 8;
constexpr int BATCH = 8, T = 2048, D = 1024, M = BATCH * T, NMEM = 256, MMEM = BATCH * NMEM, CHUNK = 64, NCH = T / CHUNK;
constexpr int NIN = 4696, NIN_PAD = 4864, PJ = 4704, DFF = 2816;
constexpr int C_GQ = 0, C_GK = 512, C_GV = 1024, C_GZ = 1536, C_DQ = 2048, C_DK = 2560, C_DV = 3072, C_IQ = 3584, C_IK = 4608, C_IW = 4672, C_GB = 4688, C_GA = 4692;
constexpr size_t MiB = 1u << 20;
constexpr size_t WS_CTL = 0, CTL_ZERO_BYTES = 1 * MiB;
constexpr size_t WS_SSQ1 = 256 * 1024, WS_SSQ2 = 320 * 1024;
constexpr size_t WS_SSQ0 = 1 * MiB, WS_SSQM = WS_SSQ0 + 65536, WS_GLAST = WS_SSQM + 8192;
constexpr size_t WS_WIN = 2 * MiB, WS_WOUT = 12 * MiB, WS_WXQ = 14 * MiB, WS_WXKV = 15 * MiB, WS_WXO = 17 * MiB, WS_WGU = 18 * MiB, WS_WDOWN = 29 * MiB;
constexpr size_t WS_MEMB = 35 * MiB, WS_KM = 39 * MiB, WS_VTM = 41 * MiB;
constexpr size_t WS_XB = 44 * MiB;
constexpr size_t WS_PROJ = 76 * MiB;
constexpr size_t WS_YMIX = 223 * MiB;
constexpr size_t WS_XQ = 76 * MiB, WS_XO = 92 * MiB, WS_ACT = 108 * MiB;
constexpr size_t WS_END = 256 * MiB;
constexpr int CW_TMO = 0, CW_CODE = 1, CW_BAR = 4096;
constexpr int RING_OFF = 0, RING_BYTES = 131072;
constexpr int LDS_BYTES = 155648;
constexpr int LDSCTL_OFF = LDS_BYTES - 512, MISC_OFF = LDSCTL_OFF + 320;
struct Frame {
    LAS unsigned char* lds;
    volatile LAS unsigned* MISC;
    gu32* ctl;
    int tid, lane, wave, vcu, G;
    const float* in[21]; float* out; unsigned char* ws;
};
enum { I_X = 0, I_MEM, I_GMIX, I_WIN, I_CONVW, I_ALOG, I_DTB, I_GGDN, I_GQD, I_GKD, I_WOUT, I_GXA, I_GMEM, I_WXQ, I_WXKV, I_GXQ, I_GXK, I_WXO, I_GFFN, I_WGU, I_WDOWN };
typedef float f32x2_t __attribute__((ext_vector_type(2))); typedef __bf16 bf16x2_t __attribute__((ext_vector_type(2)));
__device__ __forceinline__ unsigned cvtpk(float lo, float hi) { f32x2_t v = {lo, hi}; bf16x2_t b = __builtin_convertvector(v, bf16x2_t); return __builtin_bit_cast(unsigned, b); }
__device__ __forceinline__ float bf2f(unsigned short b) { return __builtin_bit_cast(float, (unsigned)b << 16); }
__device__ __forceinline__ float bflo(unsigned w) { return __builtin_bit_cast(float, w << 16); }
__device__ __forceinline__ float bfhi(unsigned w) { return __builtin_bit_cast(float, w & 0xffff0000u); }
__device__ __forceinline__ float wave_sum(float v) {
#pragma unroll
    for (int o = 1; o < 64; o <<= 1) v += __shfl_xor(v, o);
    return v;
}
__device__ __forceinline__ int srccol(int mode, int dr) {
    if (mode == 1) return dr < 2048 ? dr : (dr < 4688 ? dr + 8 : (dr < NIN ? dr - 4688 + 2048 : -1));
    if (mode == 2) { const int pn = dr >> 8, j = dr & 255; return j < 128 ? 128 * pn + j : DFF + 128 * pn + (j - 128); }
    return dr;
}
struct TrItem { const float* W; bf16* WT; const float* gain; int K, Nsrc, nblk, mode, idx; };
__device__ __forceinline__ void tr_load(const TrItem& t, int lane, f32x4 (&v)[16]) {
    const int kb = t.idx / t.nblk, nb = t.idx % t.nblk, k0 = 64 * kb, n0 = 64 * nb;
    const int c4 = (lane & 15) * 4, rr = lane >> 4;
    const int s0 = srccol(t.mode, n0 + c4);
    const bool vec = (s0 >= 0) && (srccol(t.mode, n0 + c4 + 3) == s0 + 3) && ((s0 & 3) == 0) && ((t.Nsrc & 3) == 0);
#pragma unroll
    for (int i = 0; i < 16; ++i) { const int kk = 4 * i + rr;
        if (vec) v[i] = *(const GAS f32x4*)(t.W + (size_t)(k0 + kk) * t.Nsrc + s0);
        else {
#pragma unroll
            for (int e = 0; e < 4; ++e) { const int sc = srccol(t.mode, n0 + c4 + e); v[i][e] = (sc >= 0) ? t.W[(size_t)(k0 + kk) * t.Nsrc + sc] : 0.f; } } }
}
__device__ __forceinline__ void tr_finish(const TrItem& t, int lane, f32x4 (&v)[16], LAS float* scr) {
    const int kb = t.idx / t.nblk, nb = t.idx % t.nblk, k0 = 64 * kb, n0 = 64 * nb;
    const int c4 = (lane & 15) * 4, rr = lane >> 4;
#pragma unroll
    for (int i = 0; i < 16; ++i) { const int kk = 4 * i + rr; f32x4 x = v[i]; if (t.gain) x = x * t.gain[k0 + kk];
        LAS float* d = scr + kk * 65 + c4; d[0] = x[0]; d[1] = x[1]; d[2] = x[2]; d[3] = x[3]; }
    LDS_WAIT(); asm volatile("" ::: "memory");
    const int kq = lane & 7;
#pragma unroll
    for (int j = 0; j < 8; ++j) { const int n = (lane >> 3) + 8 * j; const LAS float* s = scr + (8 * kq) * 65 + n;
        v4u o; o.x = cvtpk(s[0 * 65], s[1 * 65]); o.y = cvtpk(s[2 * 65], s[3 * 65]); o.z = cvtpk(s[4 * 65], s[5 * 65]); o.w = cvtpk(s[6 * 65], s[7 * 65]);
        *(GAS v4u*)(t.WT + (size_t)(n0 + n) * t.K + k0 + 8 * kq) = o; }
    LDS_WAIT(); asm volatile("" ::: "memory");
}
template <int NR> __device__ __forceinline__ void rows_to_bf16_ssq(Frame& F, const float* x, bf16* o, float* ssq, int m0, int stride, int mend) {
    f32x4 v[NR][4];
#pragma unroll
    for (int r = 0; r < NR; ++r) { const int m = (m0 + r * stride < mend) ? m0 + r * stride : m0; const GAS f32x4* xr = (const GAS f32x4*)(x + (size_t)m * D) + F.lane;
#pragma unroll
        for (int j = 0; j < 4; ++j) v[r][j] = xr[64 * j]; }
#pragma unroll
    for (int r = 0; r < NR; ++r) { const int m = m0 + r * stride; if (m < mend) { float s = 0.f;
#pragma unroll
        for (int j = 0; j < 4; ++j) s += (v[r][j].x * v[r][j].x + v[r][j].y * v[r][j].y) + (v[r][j].z * v[r][j].z + v[r][j].w * v[r][j].w);
        s = wave_sum(s);
        GAS unsigned long long* o8 = (GAS unsigned long long*)(o + (size_t)m * D) + F.lane;
#pragma unroll
        for (int j = 0; j < 4; ++j) o8[64 * j] = (unsigned long long)cvtpk(v[r][j].x, v[r][j].y) | ((unsigned long long)cvtpk(v[r][j].z, v[r][j].w) << 32);
        if (F.lane == 0) ssq[m] = s; } }
}
__device__ __forceinline__ void p0_transposes(Frame& F, int it_lo, int it_hi, int gw, int NGW) {
    LAS float* scr = (LAS float*)(F.lds + RING_OFF + F.wave * 17408);
    constexpr int I_0 = 16 * (NIN_PAD / 64), I_1 = 16 * 16, I_2 = 16 * 8, I_3 = 16 * 16, I_4 = 8 * 16, I_5 = 16 * (2 * DFF / 64), I_6 = (DFF / 64) * 16;
    constexpr int NITEMS = I_0 + I_1 + I_2 + I_3 + I_4 + I_5 + I_6;
    unsigned char* ws = F.ws;
    auto decode = [&](int it, TrItem& t) { int r = it;
        if (r < I_0) { t = TrItem{F.in[I_WIN], (bf16*)(ws + WS_WIN), F.in[I_GMIX], D, NIN, NIN_PAD / 64, 1, r}; return; } r -= I_0;
        if (r < I_1) { t = TrItem{F.in[I_WOUT], (bf16*)(ws + WS_WOUT), nullptr, D, D, 16, 0, r}; return; } r -= I_1;
        if (r < I_2) { t = TrItem{F.in[I_WXQ], (bf16*)(ws + WS_WXQ), F.in[I_GXA], D, 512, 8, 0, r}; return; } r -= I_2;
        if (r < I_3) { t = TrItem{F.in[I_WXKV], (bf16*)(ws + WS_WXKV), F.in[I_GMEM], D, 1024, 16, 0, r}; return; } r -= I_3;
        if (r < I_4) { t = TrItem{F.in[I_WXO], (bf16*)(ws + WS_WXO), nullptr, 512, D, 16, 0, r}; return; } r -= I_4;
        if (r < I_5) { t = TrItem{F.in[I_WGU], (bf16*)(ws + WS_WGU), F.in[I_GFFN], D, 2 * DFF, 2 * DFF / 64, 2, r}; return; } r -= I_5;
        t = TrItem{F.in[I_WDOWN], (bf16*)(ws + WS_WDOWN), nullptr, DFF, D, 16, 0, r}; };
    { int it = it_lo + gw; TrItem cur{}, nxt{}; f32x4 vc[16], vn[16];
      if (it < it_hi) { decode(it, cur); tr_load(cur, F.lane, vc); }
      while (it < it_hi) { const int itn = it + NGW; const bool more = itn < it_hi;
          if (more) { decode(itn, nxt); tr_load(nxt, F.lane, vn); }
          tr_finish(cur, F.lane, vc, scr);
          if (more) { cur = nxt;
#pragma unroll
              for (int i = 0; i < 16; ++i) vc[i] = vn[i]; }
          it = itn; } }
}
constexpr int TR_EARLY = 16 * (NIN_PAD / 64) + 16 * 16 + 16 * 8 + 16 * 16 + 8 * 16, TR_ALL = TR_EARLY + 16 * (2 * DFF / 64) + (DFF / 64) * 16;
__device__ __forceinline__ void p0_prologue(Frame& F) {
    const int gw = F.vcu * NWAVES + F.wave, NGW = F.G * NWAVES; unsigned char* ws = F.ws;
    p0_transposes(F, 0, TR_EARLY, gw, NGW);
    for (int m = gw; m < M; m += 4 * NGW) rows_to_bf16_ssq<4>(F, F.in[I_X], (bf16*)(ws + WS_XB), (float*)(ws + WS_SSQ0), m, NGW, M);
    for (int m = gw; m < MMEM; m += NGW) rows_to_bf16_ssq<1>(F, F.in[I_MEM], (bf16*)(ws + WS_MEMB), (float*)(ws + WS_SSQM), m, NGW, MMEM);
}
typedef float f32x16 __attribute__((ext_vector_type(16)));
typedef float f32x4v __attribute__((ext_vector_type(4)));
constexpr int GD_ITEM = 40960, GD_U = 0, GD_W = 16384, GD_QK = 32768, GX_ITEM = 32768, GX_QD = 0, GX_KT = 16384;
__device__ __forceinline__ int crow(int r, int hi) { return (r & 3) + 8 * (r >> 2) + 4 * hi; }
__device__ __forceinline__ float fast_exp(float x) { return __builtin_amdgcn_exp2f(x * 1.4426950408889634f); }
__device__ __forceinline__ float silu_f(float g) { return g * __builtin_amdgcn_rcpf(1.0f + __builtin_amdgcn_exp2f(g * -1.4426950408889634f)); }
constexpr int PL_KN = 0, PL_QN = 16384, PL_KT1 = 32768, PL_KT2 = 49152, PL_VT = 65536, PL_AM = 81920, PL_TF = 98304, PL_SC = 106496, PL_CW = 107520;
__device__ __forceinline__ void gdn_prep_item(Frame& F, int it) {
    int tid_ = F.tid; asm volatile("" : "+v"(tid_));
    const int tid = tid_, lane = tid & 63, wv = F.wave;
    const int bh = it >> 5, n = it & 31, b = bh >> 2, h = bh & 3;
    const bf16* PROJ = (const bf16*)(F.ws + WS_PROJ);
    unsigned char* gd = (unsigned char*)F.out + (size_t)it * GD_ITEM;
    unsigned char* gx = F.ws + WS_XB + (size_t)it * GX_ITEM;
    LAS unsigned char* L = F.lds;
    LAS float* gs = (LAS float*)(L + PL_SC); LAS float* dcy = gs + 64; LAS float* bet = gs + 128;
    const int p = tid >> 3, sg = tid & 7, t = n * 64 + p; const size_t row = (size_t)b * T + t;
    const float bl = bf2f(PROJ[row * PJ + C_GB + h]), al = bf2f(PROJ[row * PJ + C_GA + h]) + F.in[I_DTB][h];
    if (tid < 384) { const int j = tid / 96, rem = tid % 96, X = rem >> 5, c4 = (rem & 31) * 4;
        *(LAS f32x4v*)(L + PL_CW + (j * 384 + X * 128 + c4) * 4) = *(const GAS f32x4v*)(F.in[I_CONVW] + j * 1536 + X * 512 + h * 128 + c4); }
    float qv[16], kv[16], vv[16];
#pragma unroll
    for (int c = 0; c < 16; ++c) { qv[c] = 0.f; kv[c] = 0.f; vv[c] = 0.f; }
    __syncthreads();
#pragma unroll 1
    for (int jp = 0; jp < 2; ++jp) {
        v4u raw[2][3][2]; float tapw[2];
#pragma unroll
        for (int j2 = 0; j2 < 2; ++j2) { const int j = 2 * jp + j2; const bool ok = (t - 3 + j) >= 0; tapw[j2] = ok ? 1.0f : 0.0f; const bf16* rp = PROJ + (ok ? row - 3 + j : row) * PJ + h * 128 + sg * 16;
#pragma unroll
            for (int X = 0; X < 3; ++X) { raw[j2][X][0] = *(const GAS v4u*)(rp + X * 512); raw[j2][X][1] = *(const GAS v4u*)(rp + X * 512 + 8); } }
#pragma unroll
        for (int j2 = 0; j2 < 2; ++j2)
#pragma unroll
            for (int X = 0; X < 3; ++X) { const LAS f32x4v* wp = (const LAS f32x4v*)(L + PL_CW + ((2 * jp + j2) * 384 + X * 128 + sg * 16) * 4); float w[16];
#pragma unroll
                for (int q4 = 0; q4 < 4; ++q4) { const f32x4v w4 = wp[q4]; w[4 * q4] = w4[0] * tapw[j2]; w[4 * q4 + 1] = w4[1] * tapw[j2]; w[4 * q4 + 2] = w4[2] * tapw[j2]; w[4 * q4 + 3] = w4[3] * tapw[j2]; }
                const unsigned rw[8] = {raw[j2][X][0].x, raw[j2][X][0].y, raw[j2][X][0].z, raw[j2][X][0].w, raw[j2][X][1].x, raw[j2][X][1].y, raw[j2][X][1].z, raw[j2][X][1].w};
#pragma unroll
                for (int c2 = 0; c2 < 8; ++c2) { const float x0 = bflo(rw[c2]), x1 = bfhi(rw[c2]);
                    if (X == 0) { qv[2 * c2] += w[2 * c2] * x0; qv[2 * c2 + 1] += w[2 * c2 + 1] * x1; } else if (X == 1) { kv[2 * c2] += w[2 * c2] * x0; kv[2 * c2 + 1] += w[2 * c2 + 1] * x1; } else { vv[2 * c2] += w[2 * c2] * x0; vv[2 * c2 + 1] += w[2 * c2 + 1] * x1; } } }
    }
    float sq = 0.f, sk = 0.f;
#pragma unroll
    for (int c = 0; c < 16; ++c) { qv[c] = silu_f(qv[c]); kv[c] = silu_f(kv[c]); vv[c] = silu_f(vv[c]); sq += qv[c] * qv[c]; sk += kv[c] * kv[c]; }
    sq += __shfl_xor(sq, 1); sq += __shfl_xor(sq, 2); sq += __shfl_xor(sq, 4); sk += __shfl_xor(sk, 1); sk += __shfl_xor(sk, 2); sk += __shfl_xor(sk, 4);
    const float rq = __builtin_amdgcn_rsqf(sq + 1e-6f) * 0.08838834764831845f, rk = __builtin_amdgcn_rsqf(sk + 1e-6f);
    const float beta = __builtin_amdgcn_rcpf(1.0f + fast_exp(-bl));
    const float sp = (al > 20.f) ? al : __logf(1.0f + fast_exp(al));
    const float g = -__expf(F.in[I_ALOG][h]) * sp;
    if (sg == 0) { gs[p] = g; bet[p] = beta; }
    __syncthreads();
    if (wv == 0) {
        float v = gs[lane];
#pragma unroll
        for (int o = 1; o < 64; o <<= 1) { const float u = __shfl_up(v, o); if (lane >= o) v += u; }
        dcy[lane] = v;
    }
    __syncthreads();
    const float dp = dcy[p], dl = dcy[63];
    const float e_p = __expf(dp), el_p = __expf(dl - dp);
    if (tid == 0) ((float*)(F.ws + WS_GLAST))[it] = __expf(dl);
    {
        const int Fq = (p >> 5) * 8 + sg; const int l0 = (p & 31);
        unsigned kn[8], qn[8], qd[8];
#pragma unroll
        for (int c2 = 0; c2 < 8; ++c2) { kn[c2] = cvtpk(kv[2 * c2] * rk, kv[2 * c2 + 1] * rk); qn[c2] = cvtpk(qv[2 * c2] * rq, qv[2 * c2 + 1] * rq); qd[c2] = cvtpk(qv[2 * c2] * rq * e_p, qv[2 * c2 + 1] * rq * e_p); }
#pragma unroll
        for (int hf = 0; hf < 2; ++hf) { const int off = Fq * 1024 + (l0 + 32 * hf) * 16;
            *(LAS v4u*)(L + PL_KN + off) = (v4u){kn[4 * hf], kn[4 * hf + 1], kn[4 * hf + 2], kn[4 * hf + 3]};
            *(LAS v4u*)(L + PL_QN + off) = (v4u){qn[4 * hf], qn[4 * hf + 1], qn[4 * hf + 2], qn[4 * hf + 3]};
            *(GAS v4u*)(gx + GX_QD + off) = (v4u){qd[4 * hf], qd[4 * hf + 1], qd[4 * hf + 2], qd[4 * hf + 3]}; }
        const float s1 = rk * el_p, s2 = rk * beta * e_p;
#pragma unroll
        for (int c = 0; c < 16; ++c) { const int ch = sg * 16 + c;
            *(LAS unsigned short*)(L + PL_KT1 + ch * 128 + p * 2) = (unsigned short)(cvtpk(kv[c] * s1, 0.f) & 0xffffu);
            *(LAS unsigned short*)(L + PL_KT2 + ch * 128 + p * 2) = (unsigned short)(cvtpk(kv[c] * s2, 0.f) & 0xffffu);
            *(LAS unsigned short*)(L + PL_VT + ch * 128 + p * 2) = (unsigned short)(cvtpk(vv[c] * beta, 0.f) & 0xffffu); }
    }
    __syncthreads();
    {
        const int w4 = wv & 3, ta = w4 >> 1, tb = w4 & 1; const bool isqk = wv >= 4;
        f32x16 acc = {};
#pragma unroll
        for (int ks = 0; ks < 8; ++ks) { const bf16x8 a = *(const LAS bf16x8*)(L + PL_KN + (ta * 8 + ks) * 1024 + lane * 16);
            const bf16x8 bb = *(const LAS bf16x8*)(L + (isqk ? PL_QN : PL_KN) + (tb * 8 + ks) * 1024 + lane * 16);
            acc = __builtin_amdgcn_mfma_f32_32x32x16_bf16(a, bb, acc, 0, 0, 0); }
        const int hi = lane >> 5, cn = 32 * tb + (lane & 31);
        const float dn = dcy[cn];
        f32x4 dr[4], br[4];
#pragma unroll
        for (int g4 = 0; g4 < 4; ++g4) { dr[g4] = *(const LAS f32x4*)(dcy + 32 * ta + 4 * hi + 8 * g4); br[g4] = *(const LAS f32x4*)(bet + 32 * ta + 4 * hi + 8 * g4); }
        const int rbase = 32 * ta + 4 * hi;
        if (!isqk) {
#pragma unroll
            for (int r = 0; r < 16; ++r) { const int i = rbase + (r & 3) + 8 * (r >> 2); const float ex = __expf(fminf(dr[r >> 2][r & 3] - dn, 0.f));
                const float v = (i > cn) ? br[r >> 2][r & 3] * acc[r] * ex : 0.f;
                ((LAS float*)(L + PL_AM))[i * 64 + (cn & 7) * 8 + (cn >> 3)] = v; }
        } else {
#pragma unroll
            for (int gq = 0; gq < 4; ++gq) { float v[4];
#pragma unroll
                for (int e = 0; e < 4; ++e) { const int j = rbase + e + 8 * gq; const float ex = __expf(fminf(dn - dr[gq][e], 0.f)); v[e] = (cn >= j) ? acc[4 * gq + e] * ex : 0.f; }
                const int Fk = tb * 4 + 2 * ta + (gq >> 1);
                *(GAS unsigned long long*)(gd + GD_QK + Fk * 1024 + ((lane & 31) + 32 * (gq & 1)) * 16 + 8 * hi) = (unsigned long long)cvtpk(v[0], v[1]) | ((unsigned long long)cvtpk(v[2], v[3]) << 32); }
        }
    }
    __syncthreads();
    {
        const int cw = lane >> 3, r = lane & 7, c = 8 * wv + cw; float tt[8];
#pragma unroll
        for (int k = 0; k < 8; ++k) tt[k] = 0.f;
        const LAS float* AM = (const LAS float*)(L + PL_AM) + r * 8;
#pragma unroll
        for (int i = 0; i < 64; ++i) {
            float s0 = 0.f, s1 = 0.f;
            if (i > 0) { const f32x4v a0 = *(const LAS f32x4v*)(AM + i * 64); s0 = a0[0] * tt[0]; if (i > 8) s1 = a0[1] * tt[1]; if (i > 16) s0 += a0[2] * tt[2]; if (i > 24) s1 += a0[3] * tt[3]; }
            if (i > 32) { const f32x4v a1 = *(const LAS f32x4v*)(AM + i * 64 + 4); s0 += a1[0] * tt[4]; if (i > 40) s1 += a1[1] * tt[5]; if (i > 48) s0 += a1[2] * tt[6]; if (i > 56) s1 += a1[3] * tt[7]; }
            float s = s0 + s1;
            s += __builtin_bit_cast(float, __builtin_amdgcn_update_dpp(0, __builtin_bit_cast(int, s), 0xB1, 0xf, 0xf, false));
            s += __builtin_bit_cast(float, __builtin_amdgcn_update_dpp(0, __builtin_bit_cast(int, s), 0x4E, 0xf, 0xf, false));
            s += __builtin_bit_cast(float, __builtin_amdgcn_update_dpp(0, __builtin_bit_cast(int, s), 0x141, 0xf, 0xf, false));
            const float val = ((i == c) ? 1.0f : 0.0f) - s;
            tt[i >> 3] = (r == (i & 7)) ? val : tt[i >> 3];
            if ((i & 3) == 3) asm volatile("" ::: "memory");
        }
#pragma unroll
        for (int k = 0; k < 8; ++k) { const int i = 8 * k + r;
            *(LAS unsigned short*)(L + PL_TF + ((i >> 5) * 4 + (c >> 4)) * 1024 + ((i & 31) + 32 * ((c >> 3) & 1)) * 16 + (c & 7) * 2) = (unsigned short)(cvtpk(tt[k], 0.f) & 0xffffu); }
    }
    __syncthreads();
    {
        const int hi = lane >> 5;
        { const int ib = wv >> 2, e = wv & 3; f32x16 acc = {};
#pragma unroll
          for (int ks = 0; ks < 4; ++ks) { const bf16x8 a = *(const LAS bf16x8*)(L + PL_TF + (ib * 4 + ks) * 1024 + lane * 16);
              const bf16x8 bb = *(const LAS bf16x8*)(L + PL_VT + (32 * e + (lane & 31)) * 128 + (16 * ks + 8 * hi) * 2);
              acc = __builtin_amdgcn_mfma_f32_32x32x16_bf16(a, bb, acc, 0, 0, 0); }
          unsigned w[8];
#pragma unroll
          for (int r2 = 0; r2 < 8; ++r2) w[r2] = cvtpk(acc[2 * r2], acc[2 * r2 + 1]);
          GAS v4u* dst = (GAS v4u*)(gd + GD_U + (ib * 4 + e) * 2048 + lane * 32);
          dst[0] = (v4u){w[0], w[1], w[2], w[3]}; dst[1] = (v4u){w[4], w[5], w[6], w[7]}; }
        { const int a4 = wv >> 1, ib = wv & 1; f32x16 acc = {};
#pragma unroll
          for (int ks = 0; ks < 4; ++ks) { const bf16x8 a = *(const LAS bf16x8*)(L + PL_KT2 + (32 * a4 + (lane & 31)) * 128 + (16 * ks + 8 * hi) * 2);
              const bf16x8 bb = *(const LAS bf16x8*)(L + PL_TF + (ib * 4 + ks) * 1024 + lane * 16);
              acc = __builtin_amdgcn_mfma_f32_32x32x16_bf16(a, bb, acc, 0, 0, 0); }
#pragma unroll
          for (int gq = 0; gq < 4; ++gq) { const unsigned w0 = cvtpk(acc[4 * gq], acc[4 * gq + 1]), w1 = cvtpk(acc[4 * gq + 2], acc[4 * gq + 3]);
              const int Fw = ib * 8 + 2 * a4 + (gq >> 1);
              *(GAS unsigned long long*)(gd + GD_W + Fw * 1024 + ((lane & 31) + 32 * (gq & 1)) * 16 + 8 * hi) = (unsigned long long)w0 | ((unsigned long long)w1 << 32); } }
#pragma unroll
        for (int q2 = 0; q2 < 2; ++q2) { const int piece = tid + 512 * q2, Fk = piece >> 6, l2 = piece & 63; const int dk = 32 * (Fk >> 2) + (l2 & 31), pos0 = 16 * (Fk & 3) + 8 * (l2 >> 5);
            *(GAS v4u*)(gx + GX_KT + piece * 16) = *(const LAS v4u*)(L + PL_KT1 + dk * 128 + pos0 * 2); }
    }
    __syncthreads();
}
constexpr int SL_S = 0, SL_V = 32768, SL_W = 49152, SL_Q = 65536, SL_K = 81920, SL_QK = 98304, SL_O = 106496, SL_OPITCH = 528;
__device__ __forceinline__ void glds_piece(const unsigned char* gsrc_lane, LAS unsigned char* ldst_uniform) {
    __builtin_amdgcn_global_load_lds((const GAS unsigned*)gsrc_lane, (LAS unsigned*)ldst_uniform, 16, 0, 0);
}
__device__ __forceinline__ void gdn_scan_bh(Frame& F, int bh) {
    const int tid = F.tid, lane = F.lane, wv = F.wave, hi = lane >> 5, l31 = lane & 31;
    const int ib = wv & 1, e = wv >> 1, b = bh >> 2, h = bh & 3;
    LAS unsigned char* L = F.lds;
    const unsigned char* gd0 = (const unsigned char*)F.out + (size_t)(bh * 32) * GD_ITEM;
    const unsigned char* gx0 = F.ws + WS_XB + (size_t)(bh * 32) * GX_ITEM;
    const float* glast = (const float*)(F.ws + WS_GLAST) + bh * 32;
    const bf16* PROJ = (const bf16*)(F.ws + WS_PROJ); bf16* YMIX = (bf16*)(F.ws + WS_YMIX);
    for (int i = tid; i < 32768 / 16; i += 512) *(LAS v4u*)(L + SL_S + i * 16) = (v4u){0u, 0u, 0u, 0u};
    f32x16 S0 = {}, S1 = {};
    const int np = tid >> 3, dv0 = (tid & 7) * 16;
    float gout[16];
#pragma unroll
    for (int c = 0; c < 16; ++c) gout[c] = F.in[I_GGDN][dv0 + c];
#pragma unroll
    for (int q = 0; q < 2; ++q) { const int pc = wv * 2 + q; glds_piece(gd0 + GD_W + pc * 1024 + lane * 16, L + SL_W + pc * 1024); glds_piece(gx0 + GX_QD + pc * 1024 + lane * 16, L + SL_Q + pc * 1024); }
    v4u u0 = *(const GAS v4u*)(gd0 + GD_U + (ib * 4 + e) * 2048 + lane * 32), u1 = *(const GAS v4u*)(gd0 + GD_U + (ib * 4 + e) * 2048 + lane * 32 + 16);
    v4u z0 = {}, z1 = {};
    for (int n = 0; n < 32; ++n) {
        const unsigned char* gd = gd0 + (size_t)n * GD_ITEM; const unsigned char* gx = gx0 + (size_t)n * GX_ITEM;
        asm volatile("s_waitcnt vmcnt(0) lgkmcnt(0)" ::: "memory"); __builtin_amdgcn_s_barrier(); asm volatile("" ::: "memory");
#pragma unroll
        for (int q = 0; q < 2; ++q) { const int pc = wv * 2 + q; glds_piece(gx + GX_KT + pc * 1024 + lane * 16, L + SL_K + pc * 1024); }
        glds_piece(gd + GD_QK + wv * 1024 + lane * 16, L + SL_QK + wv * 1024);
        f32x16 P1 = {}, O = {};
#pragma unroll
        for (int ks = 0; ks < 8; ++ks) { const bf16x8 sb = *(const LAS bf16x8*)(L + SL_S + (e * 8 + ks) * 1024 + lane * 16);
            const bf16x8 wa = *(const LAS bf16x8*)(L + SL_W + (ib * 8 + ks) * 1024 + lane * 16), qa = *(const LAS bf16x8*)(L + SL_Q + (ib * 8 + ks) * 1024 + lane * 16);
            P1 = __builtin_amdgcn_mfma_f32_32x32x16_bf16(wa, sb, P1, 0, 0, 0); O = __builtin_amdgcn_mfma_f32_32x32x16_bf16(qa, sb, O, 0, 0, 0); }
        { const unsigned uw[8] = {u0.x, u0.y, u0.z, u0.w, u1.x, u1.y, u1.z, u1.w};
#pragma unroll
          for (int g = 0; g < 4; ++g) { const float v0 = bflo(uw[2 * g]) - P1[4 * g], v1 = bfhi(uw[2 * g]) - P1[4 * g + 1], v2 = bflo(uw[2 * g + 1]) - P1[4 * g + 2], v3 = bfhi(uw[2 * g + 1]) - P1[4 * g + 3];
              *(LAS unsigned long long*)(L + SL_V + (e * 4 + 2 * ib + (g >> 1)) * 1024 + (l31 + 32 * (g & 1)) * 16 + 8 * hi) = (unsigned long long)cvtpk(v0, v1) | ((unsigned long long)cvtpk(v2, v3) << 32); } }
        if (n > 0) { const size_t row = (size_t)b * T + (n - 1) * 64 + np; float ov[16]; float ss = 0.f;
#pragma unroll
            for (int k = 0; k < 4; ++k) { const f32x4 t4 = *(const LAS f32x4*)(L + SL_O + np * SL_OPITCH + (dv0 + 4 * k) * 4); ov[4 * k] = t4[0]; ov[4 * k + 1] = t4[1]; ov[4 * k + 2] = t4[2]; ov[4 * k + 3] = t4[3]; }
#pragma unroll
            for (int c = 0; c < 16; ++c) ss += ov[c] * ov[c];
            ss += __builtin_bit_cast(float, __builtin_amdgcn_update_dpp(0, __builtin_bit_cast(int, ss), 0xB1, 0xf, 0xf, false)); ss += __builtin_bit_cast(float, __builtin_amdgcn_update_dpp(0, __builtin_bit_cast(int, ss), 0x4E, 0xf, 0xf, false)); ss += __builtin_bit_cast(float, __builtin_amdgcn_update_dpp(0, __builtin_bit_cast(int, ss), 0x141, 0xf, 0xf, false));
            const float rs = __builtin_amdgcn_rsqf(ss * (1.0f / 128.0f) + 1e-6f);
            const unsigned zw[8] = {z0.x, z0.y, z0.z, z0.w, z1.x, z1.y, z1.z, z1.w}; unsigned ow[8];
#pragma unroll
            for (int c2 = 0; c2 < 8; ++c2) ow[c2] = cvtpk(ov[2 * c2] * rs * gout[2 * c2] * silu_f(bflo(zw[c2])), ov[2 * c2 + 1] * rs * gout[2 * c2 + 1] * silu_f(bfhi(zw[c2])));
            GAS v4u* dst = (GAS v4u*)(YMIX + row * D + h * 128 + dv0); dst[0] = (v4u){ow[0], ow[1], ow[2], ow[3]}; dst[1] = (v4u){ow[4], ow[5], ow[6], ow[7]}; }
        asm volatile("s_waitcnt vmcnt(0) lgkmcnt(0)" ::: "memory"); __builtin_amdgcn_s_barrier(); asm volatile("" ::: "memory");
        if (n < 31) {
#pragma unroll
            for (int q = 0; q < 2; ++q) { const int pc = wv * 2 + q; glds_piece(gd + GD_ITEM + GD_W + pc * 1024 + lane * 16, L + SL_W + pc * 1024); glds_piece(gx + GX_ITEM + GX_QD + pc * 1024 + lane * 16, L + SL_Q + pc * 1024); }
            u0 = *(const GAS v4u*)(gd + GD_ITEM + GD_U + (ib * 4 + e) * 2048 + lane * 32); u1 = *(const GAS v4u*)(gd + GD_ITEM + GD_U + (ib * 4 + e) * 2048 + lane * 32 + 16);
        }
        { const bf16* zp = PROJ + ((size_t)b * T + n * 64 + np) * PJ + C_GZ + h * 128 + dv0; z0 = *(const GAS v4u*)zp; z1 = *(const GAS v4u*)(zp + 8); }
        const float last = glast[n];
        bf16x8 vb[4];
#pragma unroll
        for (int ks = 0; ks < 4; ++ks) vb[ks] = *(const LAS bf16x8*)(L + SL_V + (e * 4 + ks) * 1024 + lane * 16);
#pragma unroll
        for (int ks = 0; ks < 4; ++ks) { const bf16x8 qa = *(const LAS bf16x8*)(L + SL_QK + (ib * 4 + ks) * 1024 + lane * 16); O = __builtin_amdgcn_mfma_f32_32x32x16_bf16(qa, vb[ks], O, 0, 0, 0); }
#pragma unroll
        for (int r = 0; r < 16; ++r) { S0[r] *= last; S1[r] *= last; }
#pragma unroll
        for (int ks = 0; ks < 4; ++ks) { const bf16x8 k0 = *(const LAS bf16x8*)(L + SL_K + ((2 * ib) * 4 + ks) * 1024 + lane * 16), k1 = *(const LAS bf16x8*)(L + SL_K + ((2 * ib + 1) * 4 + ks) * 1024 + lane * 16);
            S0 = __builtin_amdgcn_mfma_f32_32x32x16_bf16(k0, vb[ks], S0, 0, 0, 0); S1 = __builtin_amdgcn_mfma_f32_32x32x16_bf16(k1, vb[ks], S1, 0, 0, 0); }
#pragma unroll
        for (int r = 0; r < 16; ++r) *(LAS float*)(L + SL_O + (32 * ib + crow(r, hi)) * SL_OPITCH + (32 * e + l31) * 4) = O[r];
#pragma unroll
        for (int g = 0; g < 4; ++g) {
            *(LAS unsigned long long*)(L + SL_S + (e * 8 + 2 * (2 * ib) + (g >> 1)) * 1024 + (l31 + 32 * (g & 1)) * 16 + 8 * hi) = (unsigned long long)cvtpk(S0[4 * g], S0[4 * g + 1]) | ((unsigned long long)cvtpk(S0[4 * g + 2], S0[4 * g + 3]) << 32);
            *(LAS unsigned long long*)(L + SL_S + (e * 8 + 2 * (2 * ib + 1) + (g >> 1)) * 1024 + (l31 + 32 * (g & 1)) * 16 + 8 * hi) = (unsigned long long)cvtpk(S1[4 * g], S1[4 * g + 1]) | ((unsigned long long)cvtpk(S1[4 * g + 2], S1[4 * g + 3]) << 32); }
    }
    asm volatile("s_waitcnt vmcnt(0) lgkmcnt(0)" ::: "memory"); __builtin_amdgcn_s_barrier(); asm volatile("" ::: "memory");
    { const size_t row = (size_t)b * T + 31 * 64 + np; float ov[16]; float ss = 0.f;
#pragma unroll
      for (int k = 0; k < 4; ++k) { const f32x4 t4 = *(const LAS f32x4*)(L + SL_O + np * SL_OPITCH + (dv0 + 4 * k) * 4); ov[4 * k] = t4[0]; ov[4 * k + 1] = t4[1]; ov[4 * k + 2] = t4[2]; ov[4 * k + 3] = t4[3]; }
#pragma unroll
      for (int c = 0; c < 16; ++c) ss += ov[c] * ov[c];
      ss += __builtin_bit_cast(float, __builtin_amdgcn_update_dpp(0, __builtin_bit_cast(int, ss), 0xB1, 0xf, 0xf, false)); ss += __builtin_bit_cast(float, __builtin_amdgcn_update_dpp(0, __builtin_bit_cast(int, ss), 0x4E, 0xf, 0xf, false)); ss += __builtin_bit_cast(float, __builtin_amdgcn_update_dpp(0, __builtin_bit_cast(int, ss), 0x141, 0xf, 0xf, false));
      const float rs = __builtin_amdgcn_rsqf(ss * (1.0f / 128.0f) + 1e-6f);
      const unsigned zw[8] = {z0.x, z0.y, z0.z, z0.w, z1.x, z1.y, z1.z, z1.w}; unsigned ow[8];
#pragma unroll
      for (int c2 = 0; c2 < 8; ++c2) ow[c2] = cvtpk(ov[2 * c2] * rs * gout[2 * c2] * silu_f(bflo(zw[c2])), ov[2 * c2 + 1] * rs * gout[2 * c2 + 1] * silu_f(bfhi(zw[c2])));
      GAS v4u* dst = (GAS v4u*)(YMIX + row * D + h * 128 + dv0); dst[0] = (v4u){ow[0], ow[1], ow[2], ow[3]}; dst[1] = (v4u){ow[4], ow[5], ow[6], ow[7]}; }
    __syncthreads();
}
constexpr size_t DO_MASK = 40 * MiB, DO_VT = 44 * MiB;
constexpr float DSA_QSCALE = 0.125f * 1.4426950408889634f;
constexpr int VL_PITCH = 1040;
__device__ __forceinline__ void dsa_norm_unit(Frame& F, int u) {
    const int tid = F.tid, b = u >> 5, c = u & 31; const size_t row0 = (size_t)b * T + 64 * c;
    bf16* PROJ = (bf16*)(F.ws + WS_PROJ); LAS unsigned char* L = F.lds;
#pragma unroll 2
    for (int it = 0; it < 16; ++it) { const int idx = it * 512 + tid, vec = idx >> 3, part = idx & 7, tok = vec >> 4, hs = vec & 15;
        bf16* p = PROJ + (row0 + tok) * PJ + (hs < 8 ? C_DQ + hs * 64 : C_DK + (hs - 8) * 64) + part * 8;
        const v4u raw = *(const GAS v4u*)p; const unsigned rw[4] = {raw.x, raw.y, raw.z, raw.w}; float x[8]; float ss = 0.f;
#pragma unroll
        for (int j = 0; j < 4; ++j) { x[2 * j] = bflo(rw[j]); x[2 * j + 1] = bfhi(rw[j]); ss += x[2 * j] * x[2 * j] + x[2 * j + 1] * x[2 * j + 1]; }
        ss += __shfl_xor(ss, 1); ss += __shfl_xor(ss, 2); ss += __shfl_xor(ss, 4);
        const float rs = __builtin_amdgcn_rsqf(ss * (1.0f / 64.0f) + 1e-6f) * (hs < 8 ? DSA_QSCALE : 1.0f);
        const float* g = (hs < 8 ? F.in[I_GQD] : F.in[I_GKD]) + part * 8; unsigned o[4];
#pragma unroll
        for (int j = 0; j < 4; ++j) o[j] = cvtpk(x[2 * j] * rs * g[2 * j], x[2 * j + 1] * rs * g[2 * j + 1]);
        if (hs < 8) *(GAS v4u*)p = (v4u){o[0], o[1], o[2], o[3]};
        else { const int hk = hs - 8, tb = 64 * c + tok, kt = tb >> 5;
            *(GAS v4u*)(PROJ + ((size_t)b * T + (hk * 64 + kt) * 4 + (part >> 1)) * PJ + C_GQ + ((tb & 31) + 32 * (part & 1)) * 8) = (v4u){o[0], o[1], o[2], o[3]}; } }
#pragma unroll 2
    for (int it = 0; it < 8; ++it) { const int idx = it * 512 + tid, tok = idx >> 6, ch = idx & 63;
        *(LAS v4u*)(L + tok * VL_PITCH + ch * 16) = *(const GAS v4u*)(PROJ + (row0 + tok) * PJ + C_DV + ch * 8); }
    __syncthreads();
    { const int col = tid, h = col >> 6, d = col & 63; unsigned char* vt = (unsigned char*)F.out + DO_VT + ((size_t)(b * 8 + h) * 64 + 2 * c) * 4096 + (d >> 5) * 2048 + (d & 31) * 16;
#pragma unroll
      for (int g16 = 0; g16 < 4; ++g16) { unsigned short e[16];
#pragma unroll
          for (int k = 0; k < 16; ++k) e[k] = *(const LAS unsigned short*)(L + (16 * g16 + k) * VL_PITCH + col * 2);
          const v4u lo = {(unsigned)e[0] | ((unsigned)e[1] << 16), (unsigned)e[2] | ((unsigned)e[3] << 16), (unsigned)e[8] | ((unsigned)e[9] << 16), (unsigned)e[10] | ((unsigned)e[11] << 16)};
          const v4u hi4 = {(unsigned)e[4] | ((unsigned)e[5] << 16), (unsigned)e[6] | ((unsigned)e[7] << 16), (unsigned)e[12] | ((unsigned)e[13] << 16), (unsigned)e[14] | ((unsigned)e[15] << 16)};
          unsigned char* bp = vt + (g16 >> 1) * 4096 + (g16 & 1) * 1024; *(GAS v4u*)bp = lo; *(GAS v4u*)(bp + 512) = hi4; } }
    __syncthreads();
}
constexpr int SC_PITCH = 2052;
__device__ __forceinline__ unsigned ordkey(float f) { const unsigned uu = __float_as_uint(f); return (uu & 0x80000000u) ? ~uu : (uu | 0x80000000u); }
constexpr int SC_HIST = 16 * SC_PITCH * 4;
__device__ __forceinline__ int wave_sum_i32(int x) {
    x += __builtin_amdgcn_update_dpp(0, x, 0x111, 0xf, 0xf, true); x += __builtin_amdgcn_update_dpp(0, x, 0x112, 0xf, 0xf, true);
    x += __builtin_amdgcn_update_dpp(0, x, 0x114, 0xf, 0xf, true); x += __builtin_amdgcn_update_dpp(0, x, 0x118, 0xf, 0xf, true);
    return __builtin_amdgcn_readlane(x, 15) + __builtin_amdgcn_readlane(x, 31) + __builtin_amdgcn_readlane(x, 47) + __builtin_amdgcn_readlane(x, 63);
}
__device__ __forceinline__ int count_ge(const unsigned (&v)[32], unsigned cand) {
    int c = 0;
#pragma unroll
    for (int i = 0; i < 32; ++i) c += (v[i] >= cand) ? 1 : 0;
    return wave_sum_i32(c);
}
__device__ __forceinline__ void dsa_index_unit(Frame& F, int b, int c, int qg) {
    const int tid = F.tid, lane = F.lane, wv = F.wave, q16 = lane & 15, kg = lane >> 4;
    const size_t row0 = (size_t)b * T; const int tq0 = 64 * c + 16 * qg;
    const bf16* PROJ = (const bf16*)(F.ws + WS_PROJ); LAS unsigned char* L = F.lds;
    const bf16* qrow = PROJ + (row0 + tq0 + q16) * PJ;
    for (int i = tid; i < 1024; i += 512) *(LAS v4u*)(L + SC_HIST + i * 16) = (v4u){0u, 0u, 0u, 0u};
    const int ntile = 4 * (c + 1);
    const bf16* kbase = PROJ + (row0 + q16) * PJ + C_IK + 8 * kg;
    __syncthreads();
    LAS unsigned* hq = (LAS unsigned*)(L + SC_HIST) + q16 * 256;
    const float finf = __builtin_inff();
#pragma unroll 1
    for (int ps = 0; ps < 2; ++ps) {
        bf16x8 qf[8][2]; float wq[8];
#pragma unroll
        for (int h = 0; h < 8; ++h) { qf[h][0] = *(const GAS bf16x8*)(qrow + C_IQ + (8 * ps + h) * 64 + 8 * kg); qf[h][1] = *(const GAS bf16x8*)(qrow + C_IQ + (8 * ps + h) * 64 + 32 + 8 * kg); wq[h] = bf2f(qrow[C_IW + 8 * ps + h]) * 0.03125f; }
        bf16x8 a0 = *(const GAS bf16x8*)(kbase + (size_t)(16 * wv) * PJ), a1 = *(const GAS bf16x8*)(kbase + (size_t)(16 * wv) * PJ + 32);
        for (int kt = wv; kt < ntile; kt += 8) {
            const int ktn = (kt + 8 < ntile) ? kt + 8 : kt; const bf16* kpn = kbase + (size_t)(16 * ktn) * PJ;
            const bf16x8 n0 = *(const GAS bf16x8*)kpn, n1 = *(const GAS bf16x8*)(kpn + 32);
            LAS f32x4v* sp = (LAS f32x4v*)(L + (q16 * SC_PITCH + 16 * kt + 4 * kg) * 4);
            f32x4v sc = {0.f, 0.f, 0.f, 0.f}; if (ps) sc = *sp;
            f32x4v dd[8];
#pragma unroll
            for (int h = 0; h < 8; ++h) { dd[h] = (f32x4v){0.f, 0.f, 0.f, 0.f}; dd[h] = __builtin_amdgcn_mfma_f32_16x16x32_bf16(a0, qf[h][0], dd[h], 0, 0, 0); dd[h] = __builtin_amdgcn_mfma_f32_16x16x32_bf16(a1, qf[h][1], dd[h], 0, 0, 0); }
#pragma unroll
            for (int h = 0; h < 8; ++h)
#pragma unroll
                for (int r = 0; r < 4; ++r) sc[r] += wq[h] * __builtin_amdgcn_fmed3f(dd[h][r], 0.f, finf);
            *sp = sc;
            if (ps) {
#pragma unroll
                for (int r = 0; r < 4; ++r) { const int bk = (int)fminf(fmaxf(sc[r] * 16.0f + 128.0f, 0.f), 255.0f); __hip_atomic_fetch_add(hq + bk, 1u, __ATOMIC_RELAXED, __HIP_MEMORY_SCOPE_WORKGROUP); } }
            a0 = n0; a1 = n1;
        }
    }
    __syncthreads();
    const int nblk = c + 1;
    unsigned long long* MASK = (unsigned long long*)((unsigned char*)F.out + DO_MASK);
#pragma unroll 1
    for (int qq = 0; qq < 2; ++qq) { const int ql = 2 * wv + qq; const LAS float* sr = (const LAS float*)L + ql * SC_PITCH + lane;
        unsigned v[32];
        { float xv[32];
#pragma unroll
          for (int i = 0; i < 32; ++i) xv[i] = sr[64 * i];
#pragma unroll
          for (int i = 0; i < 32; ++i) { const unsigned msk = (i < nblk) ? 0xffffffffu : 0u; v[i] = ordkey(xv[i]) & msk; } }
        unsigned Lk = 0u, Hk = 0xffffffffu;
        { const v4u h4 = *(const LAS v4u*)(L + SC_HIST + ql * 1024 + lane * 16); const int s4 = (int)(h4.x + h4.y + h4.z + h4.w);
          int suf = s4;
#pragma unroll
          for (int o = 1; o < 64; o <<= 1) { const int t2 = __shfl_down(suf, o); if (lane + o < 64) suf += t2; }
          const unsigned long long mge = __ballot(suf >= 256); const int ls = 63 - __builtin_clzll(mge);
          int above = __builtin_amdgcn_readlane(suf, ls) - __builtin_amdgcn_readlane(s4, ls);
          const int hb[4] = {__builtin_amdgcn_readlane((int)h4.x, ls), __builtin_amdgcn_readlane((int)h4.y, ls), __builtin_amdgcn_readlane((int)h4.z, ls), __builtin_amdgcn_readlane((int)h4.w, ls)};
          int bstar = 4 * ls;
#pragma unroll
          for (int e = 3; e >= 0; --e) { if (above < 256 && above + hb[e] >= 256) bstar = 4 * ls + e; above += hb[e]; }
          if (bstar > 0) Lk = ordkey(((float)(bstar - 128)) * 0.0625f - 0.002f);
          if (bstar < 255) Hk = ordkey(((float)(bstar + 1 - 128)) * 0.0625f + 0.002f);
          if (Lk != 0u && count_ge(v, Lk) < 256) { Hk = Lk; Lk = 0u; }
          if (Hk != 0xffffffffu && count_ge(v, Hk) >= 256) { Lk = Hk; Hk = 0xffffffffu; }
        }
        unsigned thr = Lk; bool exact = false;
        while (Hk - Lk > 1u) { const unsigned mid = Lk + ((Hk - Lk) >> 1); const int cnt = count_ge(v, mid);
            if (cnt >= 256) { Lk = mid; if (cnt == 256) { exact = true; break; } } else Hk = mid; }
        thr = Lk;
        int need = 0;
        if (!exact) { int cgt = 0;
#pragma unroll
            for (int i = 0; i < 32; ++i) cgt += (v[i] > thr) ? 1 : 0;
            need = 256 - wave_sum_i32(cgt); }
        unsigned long long* mrow = MASK + (row0 + tq0 + ql) * 32; unsigned mlo = 0u, mhi = 0u;
        if (exact) {
#pragma unroll
            for (int i = 0; i < 32; ++i) { const unsigned long long mk = __ballot(v[i] >= thr); mlo = (lane == i) ? (unsigned)mk : mlo; mhi = (lane == i) ? (unsigned)(mk >> 32) : mhi; }
        } else {
#pragma unroll
            for (int i = 0; i < 32; ++i) { const bool eq = (v[i] == thr); const unsigned long long me = __ballot(eq); const int before = __popcll(me & ((1ull << lane) - 1ull));
                const unsigned long long mk = __ballot((v[i] > thr) || (eq && before < need)); need -= __popcll(me); if (need < 0) need = 0;
                mlo = (lane == i) ? (unsigned)mk : mlo; mhi = (lane == i) ? (unsigned)(mk >> 32) : mhi; }
        }
        if (lane < nblk) mrow[lane] = (unsigned long long)mlo | ((unsigned long long)mhi << 32);
    }
    __syncthreads();
}
#ifndef DSA_EARLY_STOP
#define DSA_EARLY_STOP 0
#endif
typedef short bf16x8s __attribute__((ext_vector_type(8)));
constexpr int CW_ATTNQ = 2048;
__device__ __forceinline__ float wave_min_f32(float x) {
#pragma unroll
    for (int o = 1; o < 64; o <<= 1) x = fminf(x, __shfl_xor(x, o));
    return x;
}
__device__ __forceinline__ void dsa_attn_item(Frame& F, int b, int item, float smax2) {
    const int lane = F.lane, l31 = lane & 31, hi = lane >> 5;
    const int c = 31 - (item >> 4), rem = item & 15, h = 7 - (rem >> 1), qt = rem & 1;
    const size_t row0 = (size_t)b * T; const int t0 = 64 * c, tq = t0 + 32 * qt, ntile = 2 * (c + 1);
    const bf16* PROJ = (const bf16*)(F.ws + WS_PROJ);
    const float slope2 = __builtin_amdgcn_exp2f(-(float)(h + 1)) * 1.4426950408889634f;
    bf16x8 Qf[4];
#pragma unroll
    for (int ks = 0; ks < 4; ++ks) Qf[ks] = *(const GAS bf16x8*)(PROJ + (row0 + tq + l31) * PJ + C_DQ + h * 64 + 16 * ks + 8 * hi);
    f32x16 O[2]; O[0] = (f32x16){}; O[1] = (f32x16){};
    float mrun = -1e30f, lrun = 0.f;
    const bf16* Kb = PROJ + (row0 + (size_t)h * 256) * PJ + C_GQ + lane * 8;
    const unsigned char* Vb = (const unsigned char*)F.out + DO_VT + ((size_t)(b * 8 + h) * 64) * 4096 + lane * 16;
    const unsigned* Mw = (const unsigned*)((const unsigned char*)F.out + DO_MASK) + (row0 + tq + l31) * 64;
    bf16x8 Kf[2][4]; unsigned mw[2] = {0xffffffffu, 0xffffffffu};
    { const int jp = c;
#pragma unroll
      for (int tp = 0; tp < 2; ++tp)
#pragma unroll
          for (int ks = 0; ks < 4; ++ks) Kf[tp][ks] = *(const GAS bf16x8*)(Kb + (size_t)(4 * (2 * jp + tp) + ks) * PJ);
      if (c >= 4) { const unsigned long long m2 = *(const GAS unsigned long long*)(Mw + 2 * jp); mw[0] = (unsigned)m2; mw[1] = (unsigned)(m2 >> 32); } }
    for (int jp = c; jp >= 0; --jp) {
        const int jn = jp > 0 ? jp - 1 : 0;
        bf16x8 Vf[2][2][2], Kn[2][4]; unsigned mwn[2] = {0xffffffffu, 0xffffffffu};
#pragma unroll
        for (int tp = 0; tp < 2; ++tp)
#pragma unroll
            for (int dt = 0; dt < 2; ++dt)
#pragma unroll
                for (int s = 0; s < 2; ++s) Vf[tp][dt][s] = *(const GAS bf16x8*)(Vb + (size_t)(2 * jp + tp) * 4096 + (dt * 2 + s) * 1024);
#pragma unroll
        for (int tp = 0; tp < 2; ++tp)
#pragma unroll
            for (int ks = 0; ks < 4; ++ks) Kn[tp][ks] = *(const GAS bf16x8*)(Kb + (size_t)(4 * (2 * jn + tp) + ks) * PJ);
        if (c >= 4) { const unsigned long long m2 = *(const GAS unsigned long long*)(Mw + 2 * jn); mwn[0] = (unsigned)m2; mwn[1] = (unsigned)(m2 >> 32); }
        f32x16 S[2]; S[0] = (f32x16){}; S[1] = (f32x16){};
#pragma unroll
        for (int ks = 0; ks < 4; ++ks) { S[0] = __builtin_amdgcn_mfma_f32_32x32x16_bf16(Kf[0][ks], Qf[ks], S[0], 0, 0, 0); S[1] = __builtin_amdgcn_mfma_f32_32x32x16_bf16(Kf[1][ks], Qf[ks], S[1], 0, 0, 0); }
        float mt = -INFINITY;
#pragma unroll
        for (int tp = 0; tp < 2; ++tp) { const float dq = (float)(tq + l31 - 32 * (2 * jp + tp) - 4 * hi); const unsigned wsh = mw[tp] >> (4 * hi);
#pragma unroll
            for (int r = 0; r < 16; ++r) { const int cr = (r & 3) + 8 * (r >> 2); float x = S[tp][r] - slope2 * fabsf(dq - (float)cr); x = ((wsh >> cr) & 1u) ? x : -INFINITY; S[tp][r] = x; mt = fmaxf(mt, x); } }
        { const auto rr = __builtin_amdgcn_permlane32_swap(__float_as_uint(mt), __float_as_uint(mt), false, false); mt = fmaxf(__uint_as_float(rr[0]), __uint_as_float(rr[1])); }
        const float mnew = fmaxf(mrun, mt), alpha = __builtin_amdgcn_exp2f(mrun - mnew); const bool grew = mnew > mrun; mrun = mnew;
        float ls = 0.f;
#pragma unroll
        for (int tp = 0; tp < 2; ++tp)
#pragma unroll
            for (int r = 0; r < 16; ++r) { S[tp][r] = __builtin_amdgcn_exp2f(S[tp][r] - mnew); ls += S[tp][r]; }
        lrun = lrun * alpha + ls;
        bf16x8 P[2][2];
#pragma unroll
        for (int tp = 0; tp < 2; ++tp) { unsigned pw[8];
#pragma unroll
            for (int j = 0; j < 8; ++j) pw[j] = cvtpk(S[tp][2 * j], S[tp][2 * j + 1]);
            P[tp][0] = __builtin_bit_cast(bf16x8, (v4u){pw[0], pw[1], pw[2], pw[3]}); P[tp][1] = __builtin_bit_cast(bf16x8, (v4u){pw[4], pw[5], pw[6], pw[7]}); }
        if (__any(grew)) {
#pragma unroll
            for (int dt = 0; dt < 2; ++dt)
#pragma unroll
                for (int r = 0; r < 16; ++r) O[dt][r] *= alpha; }
#pragma unroll
        for (int tp = 0; tp < 2; ++tp)
#pragma unroll
            for (int s = 0; s < 2; ++s) { O[0] = __builtin_amdgcn_mfma_f32_32x32x16_bf16(Vf[tp][0][s], P[tp][s], O[0], 0, 0, 0); O[1] = __builtin_amdgcn_mfma_f32_32x32x16_bf16(Vf[tp][1][s], P[tp][s], O[1], 0, 0, 0); }
#if DSA_EARLY_STOP
        if (jp > 0) { const float dmin = (float)(tq - 64 * jp + 1);
            if (!__any(slope2 * dmin < smax2 - mrun + 51.0f)) break; }
#endif
#pragma unroll
        for (int tp = 0; tp < 2; ++tp)
#pragma unroll
            for (int ks = 0; ks < 4; ++ks) Kf[tp][ks] = Kn[tp][ks];
        mw[0] = mwn[0]; mw[1] = mwn[1];
    }
    bf16* YMIX = (bf16*)(F.ws + WS_YMIX);
    const float lt = lrun + __shfl_xor(lrun, 32), inv = __builtin_amdgcn_rcpf(lt);
    bf16* yp = YMIX + (row0 + tq + l31) * D + 512 + h * 64 + 4 * hi;
#pragma unroll
    for (int dt = 0; dt < 2; ++dt)
#pragma unroll
        for (int g = 0; g < 4; ++g) *(GAS unsigned long long*)(yp + 32 * dt + 8 * g) = (unsigned long long)cvtpk(O[dt][4 * g] * inv, O[dt][4 * g + 1] * inv) | ((unsigned long long)cvtpk(O[dt][4 * g + 2] * inv, O[dt][4 * g + 3] * inv) << 32);
}
__device__ __forceinline__ void dsa_attn_phase(Frame& F) {
    float gq = fabsf(F.in[I_GQD][F.lane]), gk = fabsf(F.in[I_GKD][F.lane]);
#pragma unroll
    for (int o = 1; o < 64; o <<= 1) { gq = fmaxf(gq, __shfl_xor(gq, o)); gk = fmaxf(gk, __shfl_xor(gk, o)); }
    const float smax2 = 64.0f * gq * gk * DSA_QSCALE * 1.001f;
    const int x0 = (int)(xb_xcc_id() & 7u);
    for (int k = 0; k < 8; ++k) { const int bq = (x0 + k) & 7; unsigned* qh = (unsigned*)(F.ctl + CW_ATTNQ + 64 * bq);
        for (;;) { int item = 0; if (F.lane == 0) item = (int)__hip_atomic_fetch_add(qh, 1u, __ATOMIC_RELAXED, __HIP_MEMORY_SCOPE_AGENT);
            item = __builtin_amdgcn_readfirstlane(item); if (item >= NCH * 8 * 2) break;
            dsa_attn_item(F, bq, item, smax2); } }
}
constexpr size_t WS_KIF = 24 * MiB;
__device__ __forceinline__ float unkey(unsigned k) { return __uint_as_float((k & 0x80000000u) ? (k & 0x7fffffffu) : ~k); }
__device__ __forceinline__ int count_gef(const float (&v)[32], float cand, int nblk) {
    int c = 0;
#pragma unroll
    for (int g = 0; g < 4; ++g) if (8 * g < nblk) {
#pragma unroll
        for (int k = 0; k < 8; ++k) c += (v[8 * g + k] >= cand) ? 1 : 0; }
    return wave_sum_i32(c);
}
__device__ __forceinline__ int idx_pos(int r, int w, int nw) { return (r & 1) ? (r + 1) * nw - 1 - w : r * nw + w; }
template <int MODE>
__device__ __forceinline__ void dsa_index_unit2(Frame& F, int b, int c, int qg) {
    if (MODE & 128) return;
    const int tid = F.tid, lane = F.lane, wv = F.wave, q16 = lane & 15, kg = lane >> 4;
    const size_t row0 = (size_t)b * T; const int tq0 = 64 * c + 16 * qg;
    const bf16* PROJ = (const bf16*)(F.ws + WS_PROJ); LAS unsigned char* L = F.lds;
    const bf16* qrow = PROJ + (row0 + tq0 + q16) * PJ;
    for (int i = tid; i < 1024; i += 512) *(LAS v4u*)(L + SC_HIST + i * 16) = (v4u){0u, 0u, 0u, 0u};
    const int ntile = 4 * (c + 1), nblk = c + 1;
    const unsigned char* kf = F.ws + WS_KIF + (size_t)b * (128 * 2048) + lane * 16;
    __syncthreads();
    LAS unsigned* hq = (LAS unsigned*)(L + SC_HIST) + q16 * 256;
    const float finf = __builtin_inff();
    unsigned long long* MASK = (unsigned long long*)((MODE & 4) ? (F.ws + 18 * MiB) : ((unsigned char*)F.out + DO_MASK));
#pragma unroll 1
    for (int ps = 0; ps < 2; ++ps) {
        bf16x8 qf[8][2]; float wq[8];
#pragma unroll
        for (int h = 0; h < 8; ++h) { if (MODE & 256) { bf16x8 t_ = {(short)(lane + h), (short)h, 1, 2, 3, 4, 5, (short)ps}; asm volatile("" : "+v"(t_)); qf[h][0] = t_; qf[h][1] = t_; } else { qf[h][0] = *(const GAS bf16x8*)(qrow + C_IQ + (8 * ps + h) * 64 + 8 * kg); qf[h][1] = *(const GAS bf16x8*)(qrow + C_IQ + (8 * ps + h) * 64 + 32 + 8 * kg); } }
        { const v4u w4 = *(const GAS v4u*)(qrow + C_IW + 8 * ps); const unsigned ww[4] = {w4.x, w4.y, w4.z, w4.w};
#pragma unroll
          for (int j = 0; j < 4; ++j) { wq[2 * j] = bflo(ww[j]) * 0.03125f; wq[2 * j + 1] = bfhi(ww[j]) * 0.03125f; } }
        bf16x8 a0 = *(const GAS bf16x8*)(kf + (size_t)wv * 2048), a1 = *(const GAS bf16x8*)(kf + (size_t)wv * 2048 + 1024);
        for (int kt = wv; kt < ntile; kt += 8) {
            const int ktn = (kt + 8 < ntile) ? kt + 8 : kt;
            const bf16x8 n0 = *(const GAS bf16x8*)(kf + (size_t)ktn * 2048), n1 = *(const GAS bf16x8*)(kf + (size_t)ktn * 2048 + 1024);
            LAS f32x4v* sp = (LAS f32x4v*)(L + (q16 * SC_PITCH + 16 * kt + 4 * kg) * 4);
            f32x4v sc = {0.f, 0.f, 0.f, 0.f}; if (ps) sc = *sp;
            f32x4v dd[8];
#pragma unroll
            for (int h = 0; h < 8; ++h) { dd[h] = (f32x4v){0.f, 0.f, 0.f, 0.f}; dd[h] = __builtin_amdgcn_mfma_f32_16x16x32_bf16(a0, qf[h][0], dd[h], 0, 0, 0); dd[h] = __builtin_amdgcn_mfma_f32_16x16x32_bf16(a1, qf[h][1], dd[h], 0, 0, 0); }
#pragma unroll
            for (int h = 0; h < 8; ++h)
#pragma unroll
                for (int rr = 0; rr < 4; ++rr) { const float dv = dd[h][rr]; sc[rr] += wq[h] * __builtin_bit_cast(float, max(__builtin_bit_cast(int, dv), 0)); }
            *sp = sc;
            if (ps) {
#pragma unroll
                for (int rr = 0; rr < 4; ++rr) { const int bk = (int)fminf(fmaxf(sc[rr] * 16.0f + 128.0f, 0.f), 255.0f); __hip_atomic_fetch_add(hq + bk, 1u, __ATOMIC_RELAXED, __HIP_MEMORY_SCOPE_WORKGROUP); } }
            a0 = n0; a1 = n1;
        }
    }
    __syncthreads();
    {
        unsigned mres[2][2] = {{0u, 0u}, {0u, 0u}};
#pragma unroll 1
        for (int qq = 0; qq < 2; ++qq) { const int ql = 2 * wv + qq; const LAS float* sr = (const LAS float*)L + ql * SC_PITCH + lane;
            float v[32];
#pragma unroll
            for (int i = 0; i < 32; ++i) { const float x = sr[64 * i]; v[i] = (i < nblk) ? x : -finf; }
            unsigned Lk = 0u, Hk = 0xffffffffu; int cL = 64 * nblk, cH = 0;
            { const v4u h4 = *(const LAS v4u*)(L + SC_HIST + ql * 1024 + lane * 16); const int s4 = (int)(h4.x + h4.y + h4.z + h4.w);
              int px = s4;
              px += __builtin_amdgcn_update_dpp(0, px, 0x111, 0xf, 0xf, true); px += __builtin_amdgcn_update_dpp(0, px, 0x112, 0xf, 0xf, true);
              px += __builtin_amdgcn_update_dpp(0, px, 0x114, 0xf, 0xf, true); px += __builtin_amdgcn_update_dpp(0, px, 0x118, 0xf, 0xf, true);
              const int r0 = __builtin_amdgcn_readlane(px, 15), r1 = __builtin_amdgcn_readlane(px, 31), r2 = __builtin_amdgcn_readlane(px, 47), r3 = __builtin_amdgcn_readlane(px, 63);
              const int pin = px + ((lane >= 16) ? r0 : 0) + ((lane >= 32) ? r1 : 0) + ((lane >= 48) ? r2 : 0);
              const int suf = (r0 + r1 + r2 + r3) - pin + s4;
              const unsigned long long mge = __ballot(suf >= 256); const int ls = 63 - __builtin_clzll(mge);
              int above = __builtin_amdgcn_readlane(suf, ls) - __builtin_amdgcn_readlane(s4, ls);
              const int hb[4] = {__builtin_amdgcn_readlane((int)h4.x, ls), __builtin_amdgcn_readlane((int)h4.y, ls), __builtin_amdgcn_readlane((int)h4.z, ls), __builtin_amdgcn_readlane((int)h4.w, ls)};
              int bstar = 4 * ls;
#pragma unroll
              for (int e = 3; e >= 0; --e) { if (above < 256 && above + hb[e] >= 256) bstar = 4 * ls + e; above += hb[e]; }
              if (bstar > 0) { const unsigned k = ordkey(((float)(bstar - 128)) * 0.0625f - 0.002f); const int cnt = count_gef(v, unkey(k), nblk);
                  if (cnt >= 256) { Lk = k; cL = cnt; } else { Hk = k; cH = cnt; } }
              if (bstar < 255 && Hk == 0xffffffffu) { const unsigned k = ordkey(((float)(bstar + 1 - 128)) * 0.0625f + 0.002f); const int cnt = count_gef(v, unkey(k), nblk);
                  if (cnt >= 256) { Lk = k; cL = cnt; } else { Hk = k; cH = cnt; } }
            }
            bool exact = (cL == 256); int step = 0;
            while (!exact && Hk - Lk > 1u) { const unsigned span = Hk - Lk; unsigned mid = Lk + (span >> 1);
                if (!(step & 1) && Lk != 0u && Hk != 0xffffffffu) { const float t = ((float)(cL - 256) + 0.5f) / (float)(cL - cH);
                    unsigned off = (unsigned)fminf((float)span * t, 4294967040.f); off = off < 1u ? 1u : off; off = off > span - 1u ? span - 1u : off; mid = Lk + off; }
                ++step;
                const int cnt = count_gef(v, unkey(mid), nblk);
                if (cnt >= 256) { Lk = mid; cL = cnt; exact = (cnt == 256); } else { Hk = mid; cH = cnt; } }
            const float thr = unkey(Lk);
            int need = 0;
            if (!exact) { int cgt = 0;
#pragma unroll
                for (int i = 0; i < 32; ++i) cgt += (v[i] > thr) ? 1 : 0;
                need = 256 - wave_sum_i32(cgt); }
            unsigned mlo = 0u, mhi = 0u;
            if (exact) {
#pragma unroll
                for (int g = 0; g < 4; ++g) if (8 * g < nblk) {
#pragma unroll
                    for (int k = 0; k < 8; ++k) { const int i = 8 * g + k; const unsigned long long mk = __ballot(v[i] >= thr); mlo = (lane == i) ? (unsigned)mk : mlo; mhi = (lane == i) ? (unsigned)(mk >> 32) : mhi; } }
            } else {
#pragma unroll
                for (int i = 0; i < 32; ++i) { const bool eq = (v[i] == thr); const unsigned long long me = __ballot(eq); const int before = __popcll(me & ((1ull << lane) - 1ull));
                    const unsigned long long mk = __ballot((v[i] > thr) || (eq && before < need)); need -= __popcll(me); if (need < 0) need = 0;
                    mlo = (lane == i) ? (unsigned)mk : mlo; mhi = (lane == i) ? (unsigned)(mk >> 32) : mhi; }
            }
            if (qq == 0) { mres[0][0] = mlo; mres[0][1] = mhi; } else { mres[1][0] = mlo; mres[1][1] = mhi; }
        }
        if (lane < nblk) { unsigned long long* mrow = MASK + (row0 + tq0 + 2 * wv) * 32;
            mrow[lane] = (unsigned long long)mres[0][0] | ((unsigned long long)mres[0][1] << 32); mrow[32 + lane] = (unsigned long long)mres[1][0] | ((unsigned long long)mres[1][1] << 32); }
    }
    __syncthreads();
}
__device__ __forceinline__ void idx_kfrag_copy(Frame& F, int b, int c) {
    const int tok = F.tid >> 3, p = F.tid & 7, t = 64 * c + tok;
    const v4u val = *(const GAS v4u*)((const bf16*)(F.ws + WS_PROJ) + ((size_t)b * T + t) * PJ + C_IK + 8 * p);
    *(GAS v4u*)(F.ws + WS_KIF + ((size_t)(b * 128 + (t >> 4)) * 2 + (p >> 2)) * 1024 + ((p & 3) * 16 + (t & 15)) * 16) = val;
}
constexpr float XA_QSCALE = 0.08838834764831845f * 1.4426950408889634f;
__device__ __forceinline__ void xattn_unit(Frame& F, int u) {
    const int tid = F.tid, lane = F.lane, wv = F.wave, l31 = lane & 31, hi = lane >> 5;
    const int tt = u >> 2, hx = u & 3, b = tt >> 3; LAS unsigned char* L = F.lds;
    const bf16* KM = (const bf16*)(F.ws + WS_KM); const bf16* VTM = (const bf16*)(F.ws + WS_VTM); const bf16* XQ = (const bf16*)(F.ws + WS_XQ); bf16* XO = (bf16*)(F.ws + WS_XO);
    {
        const int key = tid >> 1, hf = tid & 1; const bf16* kp = KM + ((size_t)b * NMEM + key) * 512 + hx * 128 + hf * 64; const float* g = F.in[I_GXK] + hf * 64;
        unsigned rw[32]; float ss = 0.f;
#pragma unroll
        for (int q = 0; q < 8; ++q) { const v4u r4 = *(const GAS v4u*)(kp + 8 * q); rw[4 * q] = r4.x; rw[4 * q + 1] = r4.y; rw[4 * q + 2] = r4.z; rw[4 * q + 3] = r4.w; }
#pragma unroll
        for (int j = 0; j < 32; ++j) { const float a = bflo(rw[j]), c2 = bfhi(rw[j]); ss += a * a + c2 * c2; }
        ss += __shfl_xor(ss, 1);
        const float rs = __builtin_amdgcn_rsqf(ss * (1.0f / 128.0f) + 1e-6f);
#pragma unroll
        for (int q = 0; q < 8; ++q) { unsigned o[4];
#pragma unroll
            for (int j = 0; j < 4; ++j) o[j] = cvtpk(bflo(rw[4 * q + j]) * rs * g[8 * q + 2 * j], bfhi(rw[4 * q + j]) * rs * g[8 * q + 2 * j + 1]);
            const int d0 = hf * 64 + 8 * q;
            *(LAS v4u*)(L + ((key >> 5) * 8 + (d0 >> 4)) * 1024 + ((key & 31) + 32 * ((d0 >> 3) & 1)) * 16) = (v4u){o[0], o[1], o[2], o[3]}; }
    }
    {
        const int d = tid >> 2, qr = tid & 3; const bf16* vp = VTM + ((size_t)hx * 128 + d) * MMEM + (size_t)b * NMEM + qr * 64;
#pragma unroll
        for (int s4 = 0; s4 < 4; ++s4) { const v4u a = *(const GAS v4u*)(vp + 16 * s4), c4 = *(const GAS v4u*)(vp + 16 * s4 + 8);
            const int s = qr * 4 + s4; LAS unsigned char* fp = L + 65536 + ((d >> 5) * 16 + s) * 1024 + (d & 31) * 16;
            *(LAS v4u*)fp = (v4u){a.x, a.y, c4.x, c4.y};
            *(LAS v4u*)(fp + 512) = (v4u){a.z, a.w, c4.z, c4.w}; }
    }
    const size_t row = (size_t)tt * 256 + 32 * wv + l31;
    bf16x8 Qf[8];
    { const bf16* qp = XQ + row * 512 + hx * 128 + 8 * hi; unsigned rw[32]; float ss = 0.f;
#pragma unroll
      for (int ks = 0; ks < 8; ++ks) { const v4u r4 = *(const GAS v4u*)(qp + 16 * ks); rw[4 * ks] = r4.x; rw[4 * ks + 1] = r4.y; rw[4 * ks + 2] = r4.z; rw[4 * ks + 3] = r4.w; }
#pragma unroll
      for (int j = 0; j < 32; ++j) { const float a = bflo(rw[j]), c2 = bfhi(rw[j]); ss += a * a + c2 * c2; }
      ss += __shfl_xor(ss, 32);
      const float rs = __builtin_amdgcn_rsqf(ss * (1.0f / 128.0f) + 1e-6f) * XA_QSCALE; const float* g = F.in[I_GXQ] + 8 * hi;
#pragma unroll
      for (int ks = 0; ks < 8; ++ks) { unsigned o[4];
#pragma unroll
          for (int j = 0; j < 4; ++j) o[j] = cvtpk(bflo(rw[4 * ks + j]) * rs * g[16 * ks + 2 * j], bfhi(rw[4 * ks + j]) * rs * g[16 * ks + 2 * j + 1]);
          Qf[ks] = __builtin_bit_cast(bf16x8, (v4u){o[0], o[1], o[2], o[3]}); } }
    __syncthreads();
    f32x16 O[4];
#pragma unroll
    for (int dt = 0; dt < 4; ++dt) O[dt] = (f32x16){};
    float mrun = -1e30f, lrun = 0.f;
#pragma unroll 1
    for (int kt = 0; kt < 8; ++kt) {
        f32x16 S = {};
#pragma unroll
        for (int ks = 0; ks < 8; ++ks) S = __builtin_amdgcn_mfma_f32_32x32x16_bf16(*(const LAS bf16x8*)(L + (kt * 8 + ks) * 1024 + lane * 16), Qf[ks], S, 0, 0, 0);
        float mt = S[0];
#pragma unroll
        for (int r = 1; r < 16; ++r) mt = fmaxf(mt, S[r]);
        mt = fmaxf(mt, __shfl_xor(mt, 32));
        const float mnew = fmaxf(mrun, mt), alpha = __builtin_amdgcn_exp2f(mrun - mnew); mrun = mnew; float ls = 0.f;
#pragma unroll
        for (int r = 0; r < 16; ++r) { S[r] = __builtin_amdgcn_exp2f(S[r] - mnew); ls += S[r]; }
        lrun = lrun * alpha + ls;
        unsigned pw[8];
#pragma unroll
        for (int j = 0; j < 8; ++j) pw[j] = cvtpk(S[2 * j], S[2 * j + 1]);
        const bf16x8 P0 = __builtin_bit_cast(bf16x8, (v4u){pw[0], pw[1], pw[2], pw[3]}), P1 = __builtin_bit_cast(bf16x8, (v4u){pw[4], pw[5], pw[6], pw[7]});
#pragma unroll
        for (int dt = 0; dt < 4; ++dt) {
#pragma unroll
            for (int r = 0; r < 16; ++r) O[dt][r] *= alpha;
            O[dt] = __builtin_amdgcn_mfma_f32_32x32x16_bf16(*(const LAS bf16x8*)(L + 65536 + (dt * 16 + 2 * kt) * 1024 + lane * 16), P0, O[dt], 0, 0, 0);
            O[dt] = __builtin_amdgcn_mfma_f32_32x32x16_bf16(*(const LAS bf16x8*)(L + 65536 + (dt * 16 + 2 * kt + 1) * 1024 + lane * 16), P1, O[dt], 0, 0, 0); }
    }
    const float lt = lrun + __shfl_xor(lrun, 32), inv = __builtin_amdgcn_rcpf(lt);
    bf16* op = XO + row * 512 + hx * 128 + 4 * hi;
#pragma unroll
    for (int dt = 0; dt < 4; ++dt)
#pragma unroll
        for (int g = 0; g < 4; ++g) *(GAS unsigned long long*)(op + 32 * dt + 8 * g) = (unsigned long long)cvtpk(O[dt][4 * g] * inv, O[dt][4 * g + 1] * inv) | ((unsigned long long)cvtpk(O[dt][4 * g + 2] * inv, O[dt][4 * g + 3] * inv) << 32);
    __syncthreads();
}
struct Args { const float* in[21]; float* out; unsigned char* ws; int ph_lo, ph_hi, li, pad; };
__global__ void __launch_bounds__(NWAVES * 64, 2) mega(Args args) {
    extern __shared__ __attribute__((aligned(16))) unsigned char lds[];
    Frame F;
    F.lds = (LAS unsigned char*)lds;
    F.MISC = (volatile LAS unsigned*)(F.lds + MISC_OFF);
    F.tid = threadIdx.x; F.lane = F.tid & 63; F.wave = __builtin_amdgcn_readfirstlane(F.tid >> 6);
    F.G = gridDim.x; { const int bx = blockIdx.x; F.vcu = (F.G % 8 == 0) ? (bx % 8) * (F.G / 8) + bx / 8 : bx; }
    unsigned char* ws = args.ws; F.ws = ws; F.out = args.out;
    F.ctl = (gu32*)(ws + WS_CTL);
#pragma unroll
    for (int i = 0; i < 21; ++i) F.in[i] = args.in[i];
    for (int u = F.tid; u < (LDS_BYTES - LDSCTL_OFF) / 4; u += NWAVES * 64) ((LAS unsigned*)(F.lds + LDSCTL_OFF))[u] = 0u;
    __syncthreads();
    const int lo = args.ph_lo, hi = args.ph_hi;
    XcdBarrier bar; bar.bar = (unsigned*)(F.ctl + CW_BAR) + args.li * XCD_BAR_WORDS; bar.x = 0; bar.st = nullptr;
    if (hi - lo > 1) bar = xcd_barrier_post((unsigned*)(F.ctl + CW_BAR) + args.li * XCD_BAR_WORDS, F.MISC + 8);
#define IN(k) (lo <= (k) && (k) < hi)
#define BOTH(k) (IN(k) && IN((k) + 1))
#define GRID_BAR() xcd_barrier(bar)
    if (IN(0)) { p0_prologue(F); if (BOTH(0)) GRID_BAR(); }
    if (IN(1)) {
        pg8::Gemm g{(const pg8::bf16_t*)(ws + WS_XB), (const pg8::bf16_t*)(ws + WS_WIN), M, NIN_PAD, D}; pg8::StaticOrder S; S.init(M, NIN_PAD, F.G, (int)blockIdx.x);
        pg8::EpiScale E{(pg8::bf16_t*)(ws + WS_PROJ), PJ, (const float*)(ws + WS_SSQ0), NIN, (int)((size_t)M * PJ * 2)};
        pg8::gemm_phase<pg8::EpiScale, pg8::StaticOrder, true, true>(F.lds + RING_OFF, g, S, E);
        if (BOTH(1)) GRID_BAR();
    }
    if (IN(2)) {
        for (int it = blockIdx.x; it < BATCH * 4 * NCH; it += F.G) gdn_prep_item(F, it);
        for (int u = blockIdx.x; u < BATCH * NCH; u += F.G) { dsa_norm_unit(F, u); idx_kfrag_copy(F, u >> 5, u & 31); }
        GRID_BAR();
        if (blockIdx.x < 32) gdn_scan_bh(F, (int)blockIdx.x);
        else { const int xb = (int)blockIdx.x & 7, w2 = ((int)blockIdx.x - 32) >> 3, nw2 = (F.G - 32) >> 3;
               if (w2 < nw2) for (int r = 0; ; ++r) { const int pos = idx_pos(r, w2, nw2); if (r * nw2 >= 112) break; if (pos >= 112) continue;
                   dsa_index_unit2<0>(F, xb, 31 - (pos >> 2), pos & 3); } }
        if (BOTH(2)) GRID_BAR();
    }
    if (IN(3)) {
        dsa_attn_phase(F);
        if (BOTH(3)) GRID_BAR();
    }
    if (IN(4)) {
        pg8::Gemm g{(const pg8::bf16_t*)(ws + WS_YMIX), (const pg8::bf16_t*)(ws + WS_WOUT), M, D, D}; pg8::StaticOrder S; S.init(M, D, F.G, (int)blockIdx.x);
        typedef pg8::EpiRes<false, false, true> Epi4; Epi4 E{F.in[I_X], nullptr, (pg8::bf16_t*)(ws + WS_XB), (float*)(ws + WS_SSQ1), D};
        pg8::gemm_phase<Epi4, pg8::StaticOrder, true, true>(F.lds + RING_OFF, g, S, E);
        if (BOTH(4)) GRID_BAR();
    }
    if (IN(5)) {
        { pg8::Gemm g{(const pg8::bf16_t*)(ws + WS_XB), (const pg8::bf16_t*)(ws + WS_WXQ), M, 512, D}; pg8::StaticOrder S; S.init(M, 512, F.G, (int)blockIdx.x);
          pg8::EpiScale E{(pg8::bf16_t*)(ws + WS_XQ), 512, (const float*)(ws + WS_SSQ1), 512, 0};
          pg8::gemm_phase<pg8::EpiScale, pg8::StaticOrder, true, true>(F.lds + RING_OFF, g, S, E); }
        { pg8::Gemm g{(const pg8::bf16_t*)(ws + WS_MEMB), (const pg8::bf16_t*)(ws + WS_WXKV), MMEM, 512, D}; pg8::StaticOrder S; S.init(MMEM, 512, F.G, ((int)blockIdx.x + F.G - 128) % F.G);
          pg8::EpiScale E{(pg8::bf16_t*)(ws + WS_KM), 512, (const float*)(ws + WS_SSQM), 512, 0};
          pg8::gemm_phase<pg8::EpiScale, pg8::StaticOrder, true, true>(F.lds + RING_OFF, g, S, E); }
        { pg8::Gemm g{(const pg8::bf16_t*)(ws + WS_WXKV) + (size_t)512 * D, (const pg8::bf16_t*)(ws + WS_MEMB), 512, MMEM, D}; pg8::StaticOrder S; S.init(512, MMEM, F.G, ((int)blockIdx.x + F.G - 144) % F.G);
          pg8::EpiScaleCol E{(pg8::bf16_t*)(ws + WS_VTM), MMEM, (const float*)(ws + WS_SSQM)};
          pg8::gemm_phase<pg8::EpiScaleCol, pg8::StaticOrder, true, true>(F.lds + RING_OFF, g, S, E); }
        if ((int)blockIdx.x >= 160) p0_transposes(F, TR_EARLY, TR_ALL, ((int)blockIdx.x - 160) * NWAVES + F.wave, (F.G - 160) * NWAVES);
        if (BOTH(5)) GRID_BAR();
    }
    if (IN(6)) {
        for (int u = blockIdx.x; u < (M / 256) * 4; u += F.G) xattn_unit(F, u);
        if (BOTH(6)) GRID_BAR();
    }
    if (IN(7)) {
        pg8::Gemm g{(const pg8::bf16_t*)(ws + WS_XO), (const pg8::bf16_t*)(ws + WS_WXO), M, D, 512}; pg8::StaticOrder S; S.init(M, D, F.G, (int)blockIdx.x);
        typedef pg8::EpiRes<true, false, true> Epi7; Epi7 E{ws + WS_XB, nullptr, (pg8::bf16_t*)(ws + WS_XB), (float*)(ws + WS_SSQ2), D};
        pg8::gemm_phase<Epi7, pg8::StaticOrder, true, true>(F.lds + RING_OFF, g, S, E);
        if (BOTH(7)) GRID_BAR();
    }
    if (IN(8)) {
        pg8::Gemm g{(const pg8::bf16_t*)(ws + WS_XB), (const pg8::bf16_t*)(ws + WS_WGU), M, 2 * DFF, D}; pg8::StaticOrder S; S.init(M, 2 * DFF, F.G, (int)blockIdx.x);
        pg8::EpiSwiglu E{(pg8::bf16_t*)(ws + WS_ACT), DFF, (const float*)(ws + WS_SSQ2), (int)((size_t)M * DFF * 2)};
        pg8::gemm_phase<pg8::EpiSwiglu, pg8::StaticOrder, true, true>(F.lds + RING_OFF, g, S, E);
        if (BOTH(8)) GRID_BAR();
    }
    if (IN(9)) {
        pg8::Gemm g{(const pg8::bf16_t*)(ws + WS_ACT), (const pg8::bf16_t*)(ws + WS_WDOWN), M, D, DFF}; pg8::StaticOrder S; S.init(M, D, F.G, (int)blockIdx.x);
        typedef pg8::EpiRes<true, true, false> Epi9; Epi9 E{ws + WS_XB, F.out, nullptr, nullptr, D};
        pg8::gemm_phase<Epi9, pg8::StaticOrder, true, true>(F.lds + RING_OFF, g, S, E);
    }
#undef IN
#undef BOTH
}
}
extern "C" void kernel_launch(void* const* d_in, const int* in_sizes, int n_in, void* d_out, int out_size, void* d_ws, size_t ws_size, hipStream_t stream) {
  static int grid = 0;
  if (grid == 0) {
    int dev = 0, cus = 0, per_cu = 0;
    (void)hipFuncSetAttribute((const void*)mk::mega, hipFuncAttributeMaxDynamicSharedMemorySize, mk::LDS_BYTES);
    if (hipGetDevice(&dev) != hipSuccess || hipDeviceGetAttribute(&cus, hipDeviceAttributeMultiprocessorCount, dev) != hipSuccess || cus <= 0) cus = 256;
    if (hipOccupancyMaxActiveBlocksPerMultiprocessor(&per_cu, (const void*)mk::mega, mk::NWAVES * 64, mk::LDS_BYTES) != hipSuccess || per_cu < 1) { fprintf(stderr, "kernel_launch: occupancy query reports %d workgroups per CU\n", per_cu); per_cu = 1; }
    (void)hipGetLastError();
    grid = cus;
  }
  (void)hipMemsetAsync((char*)d_ws + mk::WS_CTL, 0, mk::CTL_ZERO_BYTES, stream);
  mk::Args a{}; for (int i = 0; i < 21; ++i) a.in[i] = (const float*)d_in[i]; a.out = (float*)d_out; a.ws = (unsigned char*)d_ws;
  a.ph_lo = 0; a.ph_hi = 10; a.li = 0;
  void* args[] = {&a};
  const hipError_t e = hipLaunchCooperativeKernel((const void*)mk::mega, dim3(grid), dim3(mk::NWAVES * 64), args, mk::LDS_BYTES, stream);
  if (e != hipSuccess) fprintf(stderr, "kernel_launch: cooperative launch failed: %s (grid %d)\n", hipGetErrorString(e), grid);
}
```
